# Optimizing an MI355X kernel written in HIP

```python
import jax, jax.numpy as jnp
from jax import lax
import numpy as np


D_MODEL = 1024
BATCH = 32
SEQ = 2048
DEPTH = 4

CHUNK = 64
D_MIX = D_MODEL

GLA_W = D_MIX // 2
GLA_HEADS = 4
GLA_DV = GLA_W // GLA_HEADS
GLA_DK = GLA_DV // 2
GLA_QK_W = GLA_HEADS * GLA_DK
GLA_GATE_RANK = 16
GLA_GATE_TAU = 16.0

HGRN_W = D_MIX // 4
HGRN_HEADS = 4
HGRN_DV = HGRN_W // HGRN_HEADS
HGRN_DK = 64
HGRN_QK_W = HGRN_HEADS * HGRN_DK

SB_W = D_MIX - GLA_W - HGRN_W
SB_HEADS = 4
SB_DH = SB_W // SB_HEADS
SB_BLOCK = 128

IN_WIDTHS = (GLA_QK_W, GLA_QK_W, GLA_W, GLA_GATE_RANK, GLA_W,
             HGRN_QK_W, HGRN_QK_W, HGRN_W, HGRN_W,
             SB_W, SB_W, SB_W, SB_W)
D_IN = sum(IN_WIDTHS)
EPS = 1e-6

kernel_name = 'hybrid_gla_hgrn2_stickbreaking_adaln'


def rms_norm(x):
    xf = x.astype(jnp.float32)
    y = xf * lax.rsqrt(jnp.mean(xf * xf, axis=-1, keepdims=True) + EPS)
    return y.astype(x.dtype)


def split_heads(a, n_heads):
    b, t, w = a.shape
    return a.reshape(b, t, n_heads, w // n_heads).transpose(0, 2, 1, 3)


def merge_heads(a):
    b, h, t, d = a.shape
    return a.transpose(0, 2, 1, 3).reshape(b, t, h * d)


def chunk_gated_linear_attn(q, k, v, g):
    bsz, nh, t, dk = q.shape
    dv = v.shape[-1]
    n_chunks = t // CHUNK

    def to_chunks(a):
        return a.reshape(bsz, nh, n_chunks, CHUNK, a.shape[-1]).transpose(2, 0, 1, 3, 4)

    causal = jnp.tril(jnp.ones((CHUNK, CHUNK), dtype=bool))[:, :, None]

    def step(state, inp):
        q_c, k_c, v_c, g_c = inp
        b_cum = jnp.cumsum(g_c, axis=2)
        diff = b_cum[:, :, :, None, :] - b_cum[:, :, None, :, :]
        decay = jnp.exp(jnp.where(causal, diff, -jnp.inf))
        scores = jnp.einsum('bhtd,bhsd,bhtsd->bhts', q_c, k_c, decay)
        o_c = (jnp.einsum('bhts,bhsv->bhtv', scores, v_c)
               + jnp.einsum('bhtd,bhdv->bhtv', q_c * jnp.exp(b_cum), state))
        b_last = b_cum[:, :, -1:, :]
        state = (jnp.exp(b_last[:, :, 0, :, None]) * state
                 + jnp.einsum('bhsd,bhsv->bhdv', k_c * jnp.exp(b_last - b_cum), v_c))
        return state, o_c

    s0 = jnp.zeros((bsz, nh, dk, dv), dtype=v.dtype)
    _, o = lax.scan(step, s0, (to_chunks(q), to_chunks(k), to_chunks(v), to_chunks(g)))
    return o.transpose(1, 2, 0, 3, 4).reshape(bsz, nh, t, dv)


def stick_breaking_attn(q, k, v):
    bsz, nh, t, dh = q.shape
    scale = dh ** -0.5
    outs = []
    for i in range(t // SB_BLOCK):
        n_keys = (i + 1) * SB_BLOCK
        q_blk = q[:, :, i * SB_BLOCK:n_keys]
        k_blk = k[:, :, :n_keys]
        v_blk = v[:, :, :n_keys]
        z = jnp.einsum('bhtd,bhsd->bhts', q_blk, k_blk).astype(jnp.float32) * scale
        t_pos = i * SB_BLOCK + jnp.arange(SB_BLOCK)[:, None]
        s_pos = jnp.arange(n_keys)[None, :]
        strict = s_pos < t_pos
        log_beta = jax.nn.log_sigmoid(z)
        log_1m_beta = jnp.where(strict, jax.nn.log_sigmoid(-z), 0.0)
        between = lax.cumsum(log_1m_beta, axis=3, reverse=True) - log_1m_beta
        weights = jnp.where(strict, jnp.exp(log_beta + between), 0.0)
        outs.append(jnp.einsum('bhts,bhsv->bhtv', weights.astype(v.dtype), v_blk))
    return jnp.concatenate(outs, axis=2)


def split_columns(p):
    idx = []
    acc = 0
    for w in IN_WIDTHS[:-1]:
        acc += w
        idx.append(acc)
    return jnp.split(p, idx, axis=-1)


def setup_inputs(seed: int = 0) -> dict:
    key = jax.random.key(seed)
    ks = jax.random.split(key, 12)
    f32 = jnp.float32
    x = jax.random.normal(ks[0], (BATCH, SEQ, D_MODEL), f32)
    c = jax.random.normal(ks[1], (BATCH, D_MODEL), f32)
    w_ada = jax.random.normal(ks[2], (DEPTH, D_MODEL, 3 * D_MODEL), f32) * (0.5 * D_MODEL ** -0.5)
    b_ada = 0.02 * jax.random.normal(ks[3], (DEPTH, 3 * D_MODEL), f32)
    w_in = jax.random.normal(ks[4], (DEPTH, D_MODEL, D_IN), f32) * D_MODEL ** -0.5
    w_gla_gate2 = jax.random.normal(ks[5], (DEPTH, GLA_GATE_RANK, GLA_QK_W), f32) * GLA_GATE_RANK ** -0.5
    b_gla_gate = 0.1 * jax.random.normal(ks[6], (DEPTH, GLA_QK_W), f32)
    gla_norm_w = 1.0 + 0.1 * jax.random.normal(ks[7], (DEPTH, GLA_DV), f32)
    hgrn_lb_logits = jax.random.normal(ks[8], (DEPTH, HGRN_QK_W), f32)
    hgrn_norm_w = 1.0 + 0.1 * jax.random.normal(ks[9], (DEPTH, HGRN_DV), f32)
    w_out = jax.random.normal(ks[10], (DEPTH, D_MIX, D_MODEL), f32) * D_MIX ** -0.5
    final_norm_w = 1.0 + 0.1 * jax.random.normal(ks[11], (D_MODEL,), f32)
    return {'x': x, 'c': c, 'w_ada': w_ada, 'b_ada': b_ada, 'w_in': w_in,
            'w_gla_gate2': w_gla_gate2, 'b_gla_gate': b_gla_gate, 'gla_norm_w': gla_norm_w,
            'hgrn_lb_logits': hgrn_lb_logits, 'hgrn_norm_w': hgrn_norm_w,
            'w_out': w_out, 'final_norm_w': final_norm_w}


def reference(x, c, w_ada, b_ada, w_in, w_gla_gate2, b_gla_gate, gla_norm_w,
              hgrn_lb_logits, hgrn_norm_w, w_out, final_norm_w):
    c_act = jax.nn.silu(c)
    probs = jax.nn.softmax(hgrn_lb_logits.astype(jnp.float32), axis=0)
    cum = jnp.cumsum(probs, axis=0)
    lower_bounds = (cum - cum[0:1]).astype(x.dtype)

    for l in range(DEPTH):
        ada = c_act @ w_ada[l] + b_ada[l]
        shift, scale, gate = jnp.split(ada, 3, axis=-1)
        h = rms_norm(x) * (1.0 + scale[:, None, :]) + shift[:, None, :]
        p = h @ w_in[l]
        (qa, ka, va, lra, ga,
         qb, fb, ib, gb,
         qc, kc, vc, gc) = split_columns(p)

        log_alpha = jax.nn.log_sigmoid(lra @ w_gla_gate2[l] + b_gla_gate[l]) / GLA_GATE_TAU
        o_a = chunk_gated_linear_attn(split_heads(qa, GLA_HEADS) * GLA_DK ** -0.5,
                                      split_heads(ka, GLA_HEADS),
                                      split_heads(va, GLA_HEADS),
                                      split_heads(log_alpha, GLA_HEADS))
        o_a = merge_heads(rms_norm(o_a) * gla_norm_w[l]) * jax.nn.silu(ga)

        lb = lower_bounds[l]
        log_f = jnp.logaddexp(jnp.log(lb), jnp.log1p(-lb) + jax.nn.log_sigmoid(fb))
        k_b = (1.0 - lb) * jax.nn.sigmoid(-fb)
        o_b = chunk_gated_linear_attn(split_heads(jax.nn.silu(qb), HGRN_HEADS),
                                      split_heads(k_b, HGRN_HEADS),
                                      split_heads(ib, HGRN_HEADS),
                                      split_heads(log_f, HGRN_HEADS))
        o_b = merge_heads(rms_norm(o_b) * hgrn_norm_w[l]) * jax.nn.silu(gb)

        o_c = stick_breaking_attn(split_heads(qc, SB_HEADS),
                                  split_heads(kc, SB_HEADS),
                                  split_heads(vc, SB_HEADS))
        o_c = merge_heads(o_c) * jax.nn.silu(gc)

        y = jnp.concatenate([o_a, o_b, o_c], axis=-1) @ w_out[l]
        x = x + gate[:, None, :] * y

    return rms_norm(x) * final_norm_w
```

```cpp
#include <hip/hip_runtime.h>
#include <cstdio>
#include <cstdint>
namespace pg8 {
#define PG8_LAS __attribute__((address_space(3)))
typedef unsigned short bf16_t;
typedef short bf16x8 __attribute__((ext_vector_type(8)));
typedef float f32x4 __attribute__((ext_vector_type(4)));
typedef unsigned u32x4 __attribute__((ext_vector_type(4)));
constexpr int BM = 256, BK = 64, HALF = 128, HTB = HALF * BK * 2  , STAGE_BYTES = 8 * HTB, NXCD = 8, WGM = 8;

__host__ __device__ __forceinline__ int lds_byte(int r, int c) { const int st = (r >> 4) * 2 + (c >> 5), rr = r & 15, cc = c & 31, ob = rr * 64 + cc * 2; return st * 1024 + (ob ^ (((ob >> 9) & 1) << 5)); }
__host__ __device__ __forceinline__ void stage_rc(int b, int& R, int& C) { const int st = b / 1024, sb = b % 1024, swz = sb ^ (((sb >> 9) & 1) << 5); R = (st >> 1) * 16 + swz / 64; C = (st & 1) * 32 + (swz % 64) / 2; }
__host__ __device__ __forceinline__ int perm32(int rho) { const int n = rho >> 4, i = rho & 15; return 8 * (i >> 2) + 4 * n + (i & 3); }

struct Unit { int pm, pn; };
struct Gemm { const bf16_t* A; const bf16_t* Bt; int M, N, K, wv; };
__device__ __forceinline__ int hw_lane() { unsigned m = ~0u; asm volatile("" : "+s"(m)); return (int)__builtin_amdgcn_mbcnt_hi(m, __builtin_amdgcn_mbcnt_lo(m, 0u)); }

struct StaticOrder {
    int nM, nN, nwg, G, c;
    __host__ __device__ void init(int M, int N, int G_, int c_) { nM = M / BM; nN = N / BM; nwg = nM * nN; G = G_; c = c_; }
    __host__ __device__ bool next(int i, Unit& u) const {
        const long L = (long)i * G + c; if (L >= nwg) return false;
        int wgid = (int)L; { const int q = nwg / NXCD, r = nwg % NXCD, xcd = wgid % NXCD, off = wgid / NXCD; wgid = (xcd < r ? xcd * (q + 1) : r * (q + 1) + (xcd - r) * q) + off; }
        const int nig = WGM * nN, gid = wgid / nig, fm = gid * WGM, gsz = (nM - fm) < WGM ? (nM - fm) : WGM;
        u.pm = fm + ((wgid % nig) % gsz); u.pn = (wgid % nig) / gsz; return true;
    }
    __device__ __forceinline__ void a_ready(const Unit&) const {}
    __device__ __forceinline__ void done(const Unit&) const {}
};

typedef float f32x2_t __attribute__((ext_vector_type(2))); typedef __bf16 bf16x2_t __attribute__((ext_vector_type(2)));
__device__ __forceinline__ unsigned cvt_pk_bf16(float lo, float hi) { f32x2_t v = {lo, hi}; bf16x2_t b = __builtin_convertvector(v, bf16x2_t); return __builtin_bit_cast(unsigned, b); }
template <class Epi, class Sched, bool ALIGN_EPI = false, bool SP2 = false>
__device__ __forceinline__ void gemm_phase(PG8_LAS unsigned char* lds, const Gemm g, const Sched& S, const Epi& E) {
    int tid_ = g.wv * 64 + hw_lane(); asm volatile("" : "+v"(tid_));
    const int tid = tid_, wid = __builtin_amdgcn_readfirstlane(tid >> 6), lane = tid & 63, wr = wid >> 2, wc = wid & 3, fr = lane & 15, fq = lane >> 4;
    const int K = g.K, nt = K / BK;
    unsigned voffA[2], voffB[2];
#pragma unroll
    for (int i = 0; i < 2; ++i) { int R, C; stage_rc(tid * 16 + i * 8192, R, C); const int Rb = Epi::PERM ? ((R & ~31) + perm32(R & 31)) : R;
        voffA[i] = (unsigned)(R * K + C) * 2u; voffB[i] = (unsigned)(Rb * K + C) * 2u; }
    const size_t kstep = (size_t)(BK * 2);
    const size_t hstep = (size_t)HALF * K * 2;
    const size_t tstep = 2 * hstep;
    const unsigned ldsw = (unsigned)wid * 1024u;
    const int aoff = lds_byte(wr * 64 + fr, fq * 8), boff = lds_byte(wc * 32 + fr, fq * 8);
#define PG8_SA(b, h) (((b) * 2 + (h)) * HTB)
#define PG8_SB(b, h) ((4 + (b) * 2 + (h)) * HTB)
#define PG8_STAGE(bufoff, gbase, voff) do { _Pragma("unroll") for (int _i = 0; _i < 2; ++_i) \
        __builtin_amdgcn_global_load_lds((const unsigned*)((const char*)(gbase) + (voff)[_i]), (PG8_LAS unsigned*)(lds + (bufoff) + ldsw + _i * 8192), 16, 0, 0); } while (0)
#define PG8_LDA(dst, b, h) do { _Pragma("unroll") for (int m = 0; m < 4; ++m) _Pragma("unroll") for (int k = 0; k < 2; ++k) dst[m][k] = *(const PG8_LAS bf16x8*)(lds + PG8_SA(b, h) + aoff + m * 2048 + k * 1024); } while (0)
#define PG8_LDB(dst, b, h) do { _Pragma("unroll") for (int n = 0; n < 2; ++n) _Pragma("unroll") for (int k = 0; k < 2; ++k) dst[n][k] = *(const PG8_LAS bf16x8*)(lds + PG8_SB(b, h) + boff + n * 2048 + k * 1024); } while (0)
#define PG8_MMA(ai, bj, At, Bt) do { __builtin_amdgcn_s_setprio(1); _Pragma("unroll") for (int m = 0; m < 4; ++m) _Pragma("unroll") for (int n = 0; n < 2; ++n) _Pragma("unroll") for (int k = 0; k < 2; ++k) \
        acc[ai][bj][m][n] = __builtin_amdgcn_mfma_f32_16x16x32_bf16(Bt[n][k], At[m][k], acc[ai][bj][m][n], 0, 0, 0); __builtin_amdgcn_s_setprio(0); } while (0)
#define PG8_WAIT_V(n) asm volatile("s_waitcnt vmcnt(" #n ")" ::: "memory")
#define PG8_WAIT_L(n) asm volatile("s_waitcnt lgkmcnt(" #n ")" ::: "memory")
#define PG8_BAR __builtin_amdgcn_s_barrier()
#define PG8_SCHED __builtin_amdgcn_sched_barrier(0)
    Unit cur, nxt; int ui = 0;
    if (!S.next(0, cur)) return;
    f32x4 acc[2][2][4][2];
#pragma unroll
    for (int a = 0; a < 2; ++a)
#pragma unroll
        for (int b = 0; b < 2; ++b)
#pragma unroll
            for (int m = 0; m < 4; ++m)
#pragma unroll
                for (int n = 0; n < 2; ++n) acc[a][b][m][n] = (f32x4){0.f, 0.f, 0.f, 0.f};
    bf16x8 At[4][2], B0[2][2], B1[2][2];
    const char* cA = (const char*)g.A + (size_t)cur.pm * tstep; const char* cB = (const char*)g.Bt + (size_t)cur.pn * tstep;
    S.a_ready(cur);
    if constexpr (SP2) {
        PG8_STAGE(PG8_SB(0, 0), cB, voffB); PG8_STAGE(PG8_SB(0, 1), cB + hstep, voffB); PG8_STAGE(PG8_SA(0, 0), cA, voffA); PG8_STAGE(PG8_SA(0, 1), cA + hstep, voffA);
        if (wr == 1) PG8_BAR;
        PG8_WAIT_V(2); PG8_BAR;
        PG8_STAGE(PG8_SB(1, 0), cB + kstep, voffB); PG8_STAGE(PG8_SA(1, 0), cA + kstep, voffA); PG8_STAGE(PG8_SB(1, 1), cB + hstep + kstep, voffB);
        PG8_WAIT_V(6); PG8_BAR;
    } else {
        PG8_STAGE(PG8_SB(0, 0), cB, voffB); PG8_STAGE(PG8_SA(0, 0), cA, voffA); PG8_STAGE(PG8_SB(0, 1), cB + hstep, voffB); PG8_STAGE(PG8_SA(0, 1), cA + hstep, voffA);
        if (wr == 1) PG8_BAR;
        PG8_WAIT_V(4); PG8_BAR;
        PG8_STAGE(PG8_SB(1, 0), cB + kstep, voffB); PG8_STAGE(PG8_SA(1, 0), cA + kstep, voffA); PG8_STAGE(PG8_SB(1, 1), cB + hstep + kstep, voffB);
        PG8_WAIT_V(6); PG8_BAR;
    }
    for (;;) {
        const bool has_next = S.next(ui + 1, nxt);
        const char* nA = has_next ? (const char*)g.A + (size_t)nxt.pm * tstep : cA; const char* nB = has_next ? (const char*)g.Bt + (size_t)nxt.pn * tstep : cB;
        for (int t = 0; t < nt; t += 2) {
            const bool last = (t == nt - 2);
            const char* a1 = cA + (size_t)(t + 1) * kstep;
            const char* a2 = last ? nA : cA + (size_t)(t + 2) * kstep; const char* b2 = last ? nB : cB + (size_t)(t + 2) * kstep;
            const char* a3 = a2 + kstep; const char* b3 = b2 + kstep;
            if (last && has_next) S.a_ready(nxt);
            if constexpr (SP2) {
            PG8_LDB(B0, 0, 0); PG8_LDB(B1, 0, 1); PG8_SCHED; PG8_LDA(At, 0, 0); PG8_STAGE(PG8_SA(1, 1), a1 + hstep, voffA);
            PG8_WAIT_V(8); PG8_WAIT_L(0); PG8_BAR; PG8_MMA(0, 0, At, B0); PG8_MMA(0, 1, At, B1); PG8_BAR; PG8_SCHED;
            PG8_LDA(At, 0, 1); PG8_STAGE(PG8_SB(0, 0), b2, voffB); PG8_STAGE(PG8_SB(0, 1), b2 + hstep, voffB); PG8_STAGE(PG8_SA(0, 0), a2, voffA);
            PG8_WAIT_V(8); PG8_WAIT_L(0); PG8_BAR; PG8_MMA(1, 0, At, B0); PG8_MMA(1, 1, At, B1); PG8_BAR; PG8_SCHED;
            PG8_LDB(B0, 1, 0); PG8_LDB(B1, 1, 1); PG8_SCHED; PG8_LDA(At, 1, 0); PG8_STAGE(PG8_SA(0, 1), a2 + hstep, voffA);
            PG8_WAIT_V(8); PG8_WAIT_L(0); PG8_BAR; PG8_MMA(0, 0, At, B0); PG8_MMA(0, 1, At, B1); PG8_BAR; PG8_SCHED;
            PG8_LDA(At, 1, 1); PG8_STAGE(PG8_SB(1, 0), b3, voffB); PG8_STAGE(PG8_SB(1, 1), b3 + hstep, voffB); PG8_STAGE(PG8_SA(1, 0), a3, voffA);
            PG8_WAIT_V(8); PG8_WAIT_L(0); PG8_BAR; PG8_MMA(1, 0, At, B0); PG8_MMA(1, 1, At, B1); PG8_BAR; PG8_SCHED;
            } else {
            PG8_LDB(B0, 0, 0); PG8_SCHED; PG8_LDA(At, 0, 0); PG8_STAGE(PG8_SA(1, 1), a1 + hstep, voffA);
            PG8_WAIT_L(8); PG8_BAR; PG8_WAIT_L(0); PG8_MMA(0, 0, At, B0); PG8_BAR; PG8_SCHED;
            PG8_LDB(B1, 0, 1); PG8_STAGE(PG8_SB(0, 0), b2, voffB);
            PG8_BAR; PG8_WAIT_L(0); PG8_MMA(0, 1, At, B1); PG8_BAR;
            PG8_LDA(At, 0, 1); PG8_STAGE(PG8_SA(0, 0), a2, voffA);
            PG8_BAR; PG8_WAIT_L(0); PG8_MMA(1, 0, At, B0); PG8_BAR; PG8_SCHED;
            PG8_STAGE(PG8_SB(0, 1), b2 + hstep, voffB);
            PG8_WAIT_V(6); PG8_BAR; PG8_MMA(1, 1, At, B1); PG8_BAR;
            PG8_LDB(B0, 1, 0); PG8_SCHED; PG8_LDA(At, 1, 0); PG8_STAGE(PG8_SA(0, 1), a2 + hstep, voffA);
            PG8_WAIT_L(8); PG8_BAR; PG8_WAIT_L(0); PG8_MMA(0, 0, At, B0); PG8_BAR; PG8_SCHED;
            PG8_LDB(B1, 1, 1); PG8_STAGE(PG8_SB(1, 0), b3, voffB);
            PG8_BAR; PG8_WAIT_L(0); PG8_MMA(0, 1, At, B1); PG8_BAR;
            PG8_LDA(At, 1, 1); PG8_STAGE(PG8_SA(1, 0), a3, voffA);
            PG8_BAR; PG8_WAIT_L(0); PG8_MMA(1, 0, At, B0); PG8_BAR; PG8_SCHED;
            PG8_STAGE(PG8_SB(1, 1), b3 + hstep, voffB);
            PG8_WAIT_V(6); PG8_BAR; PG8_MMA(1, 1, At, B1); PG8_BAR;
            }
        }
        if constexpr (ALIGN_EPI) { if (wr == 0) PG8_BAR; }
        if constexpr (!Epi::AFTER_DRAIN) { E(acc, cur, wr, wc, fr, fq); S.done(cur); }
        if (!has_next) break;
#pragma unroll
        for (int a = 0; a < 2; ++a)
#pragma unroll
            for (int b = 0; b < 2; ++b)
#pragma unroll
                for (int m = 0; m < 4; ++m)
#pragma unroll
                    for (int n = 0; n < 2; ++n) acc[a][b][m][n] = (f32x4){0.f, 0.f, 0.f, 0.f};
        cur = nxt; cA = nA; cB = nB; ++ui;
        if constexpr (ALIGN_EPI) { if (wr == 1) PG8_BAR; }
    }
    PG8_WAIT_V(0);
    if constexpr (!ALIGN_EPI) { if (wr == 0) PG8_BAR; }
    PG8_BAR;
    if constexpr (Epi::AFTER_DRAIN) { E.fused(acc, cur, wr, wc, fr, fq, lds, wid, lane); S.done(cur); }
#undef PG8_SA
#undef PG8_SB
#undef PG8_STAGE
#undef PG8_LDA
#undef PG8_LDB
#undef PG8_MMA
#undef PG8_WAIT_V
#undef PG8_WAIT_L
#undef PG8_BAR
#undef PG8_SCHED
}
}
constexpr int NWAVES = 8, NTHR = 512;
constexpr int BATCH = 32, T = 2048, D = 1024, DEPTH = 4, M = BATCH * T;
constexpr int DIN = 3600, NIN = 3840;
constexpr float EPS = 1e-6f, LOG2E = 1.4426950408889634f;
#ifndef MK_PER_PHASE
#define MK_PER_PHASE 0
#endif
constexpr int N_PHASES = 2 + 3 * DEPTH;

constexpr size_t MiB = 1u << 20;
constexpr size_t WS_CTL = 0, CTL_ZERO_BYTES = 1 * MiB;
constexpr size_t WS_ADA = 2 * MiB;
constexpr size_t WS_LB = 3 * MiB + 512 * 1024;
constexpr size_t WS_WIN = 4 * MiB;
constexpr size_t WS_WOUT = 34 * MiB;
constexpr size_t WS_HN = 64 * MiB;
constexpr size_t WS_O = 192 * MiB;
constexpr size_t WS_P = 320 * MiB;
constexpr size_t P_QA = 0, P_KA = 32 * MiB, P_VA = 64 * MiB, P_GA = 128 * MiB, P_QB = 192 * MiB, P_GFB = 224 * MiB, P_KB = 256 * MiB, P_IB = 288 * MiB,
                 P_GB = 320 * MiB, P_QC = 352 * MiB, P_KC = 384 * MiB, P_VC = 416 * MiB, P_GC = 448 * MiB, P_LRA = 480 * MiB;
constexpr size_t WS_XB = WS_P + 482 * MiB;
constexpr size_t WS_PART = WS_XB + 128 * MiB;
constexpr size_t WS_END = WS_PART + 16 * MiB;
constexpr int CW_PANEL = 16384;
constexpr int CW_TMO = 0, CW_CODE = 1, CW_BAR = 4096;

constexpr int RING_BYTES = 139264, LDSCTL_OFF = RING_BYTES, MISC_OFF = LDSCTL_OFF + 320, LDS_BYTES = 147456;

#define GAS __attribute__((address_space(1)))
#define LAS __attribute__((address_space(3)))
typedef unsigned short bf16;
typedef unsigned v4u __attribute__((ext_vector_type(4)));
typedef unsigned v2u __attribute__((ext_vector_type(2)));
typedef float f32x4 __attribute__((ext_vector_type(4)));
typedef GAS unsigned gu32;
#define RLX_AGENT __ATOMIC_RELAXED, __HIP_MEMORY_SCOPE_AGENT
#define LDS_WAIT() asm volatile("s_waitcnt lgkmcnt(0)" ::: "memory")
__device__ __forceinline__ unsigned f2bf(float f) { unsigned u = __builtin_bit_cast(unsigned, f); return (u + 0x7fffu + ((u >> 16) & 1u)) >> 16; }
__device__ __forceinline__ unsigned pk2(float lo, float hi) { return f2bf(lo) | (f2bf(hi) << 16); }
__device__ __forceinline__ float bflo(unsigned w) { return __uint_as_float(w << 16); }
__device__ __forceinline__ float bfhi(unsigned w) { return __uint_as_float(w & 0xffff0000u); }
__device__ __forceinline__ float ex2(float x) { return __builtin_amdgcn_exp2f(x); }
__device__ __forceinline__ float lg2(float x) { return __builtin_amdgcn_logf(x); }
__device__ __forceinline__ float rcpf_(float x) { return __builtin_amdgcn_rcpf(x); }
__device__ __forceinline__ float silu_f(float x) { return x * rcpf_(1.0f + ex2(-x * LOG2E)); }
__device__ __forceinline__ float softplus2(float z) { return fmaxf(z, 0.f) + lg2(1.0f + ex2(-fabsf(z))); }
__device__ __forceinline__ float wave_sum(float v) {
#pragma unroll
    for (int o = 1; o < 64; o <<= 1) v += __shfl_xor(v, o);
    return v;
}
namespace pg8 {
struct EpiIn {
    static constexpr bool PERM = true, AFTER_DRAIN = false;
    unsigned char* P;
    const float* lb;
    __device__ __forceinline__ void operator()(const f32x4 (&acc)[2][2][4][2], const Unit& u, int wr, int wc, int fr, int fq) const {
        const int pn = u.pn;
        size_t off; int ldc = 256, colt = 0, mode = 0; float scl = 1.f;
        if (pn == 0) { off = P_QA; scl = 0.125f; }
        else if (pn == 1) { off = P_KA; }
        else if (pn == 2) { off = P_VA; ldc = 512; }
        else if (pn == 3) { off = P_VA; ldc = 512; colt = 256; }
        else if (pn == 4) { off = P_GA; ldc = 512; mode = 2; }
        else if (pn == 5) { off = P_GA; ldc = 512; colt = 256; mode = 2; }
        else if (pn == 6) { off = P_QB; mode = 2; }
        else if (pn == 7) { off = P_GFB; mode = 3; }
        else if (pn == 8) { off = P_IB; }
        else if (pn == 9) { off = P_GB; mode = 2; }
        else if (pn == 10) { off = P_QC; scl = 0.125f * LOG2E; }
        else if (pn == 11) { off = P_KC; }
        else if (pn == 12) { off = P_VC; }
        else if (pn == 13) { off = P_GC; mode = 2; }
        else { off = P_LRA; ldc = 16; mode = 4; }
        bf16_t* base = (bf16_t*)(P + off);
        const int row0 = u.pm * BM + wr * 64 + fr, cl = wc * 32 + 8 * fq;
        if (mode == 3) {
            bf16_t* kbase = (bf16_t*)(P + P_KB);
#pragma unroll
            for (int bj = 0; bj < 2; ++bj) {
                const f32x4 l0 = *(const f32x4*)(lb + bj * HALF + cl), l1 = *(const f32x4*)(lb + bj * HALF + cl + 4);
                const float lbv[8] = {l0[0], l0[1], l0[2], l0[3], l1[0], l1[1], l1[2], l1[3]};
#pragma unroll
                for (int ai = 0; ai < 2; ++ai)
#pragma unroll
                    for (int m = 0; m < 4; ++m) {
                        const size_t o = (size_t)(row0 + ai * HALF + m * 16) * 256 + cl + bj * HALF;
                        const f32x4 v0 = acc[ai][bj][m][0], v1 = acc[ai][bj][m][1];
                        const float x[8] = {v0[0], v0[1], v0[2], v0[3], v1[0], v1[1], v1[2], v1[3]};
                        float g[8], kk[8];
#pragma unroll
                        for (int j = 0; j < 8; ++j) { const float s = rcpf_(1.0f + ex2(-x[j] * LOG2E)); const float f = lbv[j] + (1.0f - lbv[j]) * s; g[j] = fmaxf(lg2(f), -200.f); kk[j] = (1.0f - lbv[j]) * (1.0f - s); }
                        u32x4 w; w.x = cvt_pk_bf16(g[0], g[1]); w.y = cvt_pk_bf16(g[2], g[3]); w.z = cvt_pk_bf16(g[4], g[5]); w.w = cvt_pk_bf16(g[6], g[7]);
                        *(u32x4*)(base + o) = w;
                        w.x = cvt_pk_bf16(kk[0], kk[1]); w.y = cvt_pk_bf16(kk[2], kk[3]); w.z = cvt_pk_bf16(kk[4], kk[5]); w.w = cvt_pk_bf16(kk[6], kk[7]);
                        *(u32x4*)(kbase + o) = w;
                    }
            }
        } else if (mode == 4) {
            if (wc == 0 && fq < 2) {
#pragma unroll
                for (int ai = 0; ai < 2; ++ai)
#pragma unroll
                    for (int m = 0; m < 4; ++m) {
                        const f32x4 v0 = acc[ai][0][m][0], v1 = acc[ai][0][m][1];
                        u32x4 w; w.x = cvt_pk_bf16(v0[0], v0[1]); w.y = cvt_pk_bf16(v0[2], v0[3]); w.z = cvt_pk_bf16(v1[0], v1[1]); w.w = cvt_pk_bf16(v1[2], v1[3]);
                        *(u32x4*)(base + (size_t)(row0 + ai * HALF + m * 16) * 16 + 8 * fq) = w;
                    }
            }
        } else {
#pragma unroll
            for (int ai = 0; ai < 2; ++ai)
#pragma unroll
                for (int m = 0; m < 4; ++m) {
                    bf16_t* rowp = base + (size_t)(row0 + ai * HALF + m * 16) * ldc + colt + cl;
#pragma unroll
                    for (int bj = 0; bj < 2; ++bj) {
                        f32x4 v0 = acc[ai][bj][m][0], v1 = acc[ai][bj][m][1];
                        if (mode == 2) {
#pragma unroll
                            for (int j = 0; j < 4; ++j) { v0[j] = silu_f(v0[j]); v1[j] = silu_f(v1[j]); }
                        } else { v0 = v0 * scl; v1 = v1 * scl; }
                        u32x4 w; w.x = cvt_pk_bf16(v0[0], v0[1]); w.y = cvt_pk_bf16(v0[2], v0[3]); w.z = cvt_pk_bf16(v1[0], v1[1]); w.w = cvt_pk_bf16(v1[2], v1[3]);
                        *(u32x4*)(rowp + bj * HALF) = w;
                    }
                }
        }
    }
};
typedef _Float16 h2v_ __attribute__((ext_vector_type(2)));
typedef float f2v_ __attribute__((ext_vector_type(2)));
__device__ __forceinline__ unsigned pk_f16(float a, float b) { f2v_ v = {a, b}; return __builtin_bit_cast(unsigned, __builtin_convertvector(v, h2v_)); }
__device__ __forceinline__ float f16_lo(unsigned w) { return (float)__builtin_bit_cast(h2v_, w)[0]; }
__device__ __forceinline__ float f16_hi(unsigned w) { return (float)__builtin_bit_cast(h2v_, w)[1]; }
template <bool XF32, bool LAST>
struct EpiNorm {
    static constexpr bool PERM = true, AFTER_DRAIN = false;
    const float* X32;
    bf16_t* XB;
    const float* gate;
    const float* mod;
    bf16_t* HN; float* OUT;
    float* part;
    unsigned* cnt;
    __device__ __forceinline__ void operator()(f32x4 (&acc)[2][2][4][2], const Unit& u, int wr, int wc, int fr_, int fq_) const {
        int ln_ = fq_ * 16 + fr_; asm volatile("" : "+v"(ln_));
        const int fr = ln_ & 15, fq = ln_ >> 4;
        const int row0 = u.pm * BM + wr * 64 + fr, col0 = u.pn * BM + wc * 32 + 8 * fq, b = u.pm >> 3;
        float ss[2][4];
        {
            const float* gp = gate + (size_t)b * 3072 + col0;
            f32x4 g[2][2];
#pragma unroll
            for (int bj = 0; bj < 2; ++bj) { g[bj][0] = *(const f32x4*)(gp + bj * HALF); g[bj][1] = *(const f32x4*)(gp + bj * HALF + 4); }
#pragma unroll
            for (int ai = 0; ai < 2; ++ai) {
                if constexpr (XF32) {
#pragma unroll
                    for (int mh = 0; mh < 2; ++mh) {
                        f32x4 xo[2][2][2];
#pragma unroll
                        for (int m2 = 0; m2 < 2; ++m2)
#pragma unroll
                            for (int bj = 0; bj < 2; ++bj) { const float* xp = X32 + (size_t)(row0 + ai * HALF + (2 * mh + m2) * 16) * D + col0 + bj * HALF; xo[m2][bj][0] = *(const f32x4*)xp; xo[m2][bj][1] = *(const f32x4*)(xp + 4); }
#pragma unroll
                        for (int m2 = 0; m2 < 2; ++m2) { const int m = 2 * mh + m2; float s = 0.f;
#pragma unroll
                            for (int bj = 0; bj < 2; ++bj) {
                                const f32x4 v0 = xo[m2][bj][0] + g[bj][0] * acc[ai][bj][m][0], v1 = xo[m2][bj][1] + g[bj][1] * acc[ai][bj][m][1];
                                acc[ai][bj][m][0] = v0; acc[ai][bj][m][1] = v1;
                                s += (v0[0] * v0[0] + v0[1] * v0[1]) + (v0[2] * v0[2] + v0[3] * v0[3]) + (v1[0] * v1[0] + v1[1] * v1[1]) + (v1[2] * v1[2] + v1[3] * v1[3]);
                                if constexpr (!LAST) { u32x4 w; w.x = pk_f16(v0[0], v0[1]); w.y = pk_f16(v0[2], v0[3]); w.z = pk_f16(v1[0], v1[1]); w.w = pk_f16(v1[2], v1[3]);
                                    *(u32x4*)(XB + (size_t)(row0 + ai * HALF + m * 16) * D + col0 + bj * HALF) = w; }
                            }
                            ss[ai][m] = s; }
                    }
                } else {
                    u32x4 xo[4][2];
#pragma unroll
                    for (int m = 0; m < 4; ++m)
#pragma unroll
                        for (int bj = 0; bj < 2; ++bj) xo[m][bj] = *(const u32x4*)(XB + (size_t)(row0 + ai * HALF + m * 16) * D + col0 + bj * HALF);
#pragma unroll
                    for (int m = 0; m < 4; ++m) { float s = 0.f;
#pragma unroll
                        for (int bj = 0; bj < 2; ++bj) {
                            const u32x4 x = xo[m][bj];
                            const f32x4 x0 = {f16_lo(x.x), f16_hi(x.x), f16_lo(x.y), f16_hi(x.y)}, x1 = {f16_lo(x.z), f16_hi(x.z), f16_lo(x.w), f16_hi(x.w)};
                            const f32x4 v0 = x0 + g[bj][0] * acc[ai][bj][m][0], v1 = x1 + g[bj][1] * acc[ai][bj][m][1];
                            acc[ai][bj][m][0] = v0; acc[ai][bj][m][1] = v1;
                            s += (v0[0] * v0[0] + v0[1] * v0[1]) + (v0[2] * v0[2] + v0[3] * v0[3]) + (v1[0] * v1[0] + v1[1] * v1[1]) + (v1[2] * v1[2] + v1[3] * v1[3]);
                            if constexpr (!LAST) { u32x4 w; w.x = pk_f16(v0[0], v0[1]); w.y = pk_f16(v0[2], v0[3]); w.z = pk_f16(v1[0], v1[1]); w.w = pk_f16(v1[2], v1[3]);
                                *(u32x4*)(XB + (size_t)(row0 + ai * HALF + m * 16) * D + col0 + bj * HALF) = w; }
                        }
                        ss[ai][m] = s; }
                }
            }
        }
#pragma unroll
        for (int ai = 0; ai < 2; ++ai)
#pragma unroll
            for (int m = 0; m < 4; ++m) { float s = ss[ai][m]; s += __shfl_xor(s, 16); s += __shfl_xor(s, 32);
                if (fq == 0) __hip_atomic_store(part + (size_t)(row0 + ai * HALF + m * 16) * 16 + u.pn * 4 + wc, s, __ATOMIC_RELAXED, __HIP_MEMORY_SCOPE_AGENT); }
        asm volatile("s_waitcnt vmcnt(0)" ::: "memory");
        __syncthreads();
        if (wr == 0 && wc == 0 && fr == 0 && fq == 0) {
            unsigned* c = cnt + u.pm * 16;
            (void)__hip_atomic_fetch_add(c, 1u, __ATOMIC_RELAXED, __HIP_MEMORY_SCOPE_AGENT);
            unsigned sp = 0;
            while (__hip_atomic_load(c, __ATOMIC_RELAXED, __HIP_MEMORY_SCOPE_AGENT) < 4u) { __builtin_amdgcn_s_sleep(1); if (++sp > (1u << 22)) break; }
        }
        asm volatile("" ::: "memory");
        __syncthreads();
        float rstd[2][4];
#pragma unroll
        for (int ai = 0; ai < 2; ++ai)
#pragma unroll
            for (int m = 0; m < 4; ++m) { unsigned long long* p = (unsigned long long*)(part + (size_t)(row0 + ai * HALF + m * 16) * 16 + 4 * fq);
                const unsigned long long q0 = __hip_atomic_load(p, __ATOMIC_RELAXED, __HIP_MEMORY_SCOPE_AGENT), q1 = __hip_atomic_load(p + 1, __ATOMIC_RELAXED, __HIP_MEMORY_SCOPE_AGENT);
                float s = (__builtin_bit_cast(float, (unsigned)q0) + __builtin_bit_cast(float, (unsigned)(q0 >> 32))) + (__builtin_bit_cast(float, (unsigned)q1) + __builtin_bit_cast(float, (unsigned)(q1 >> 32)));
                s += __shfl_xor(s, 16); s += __shfl_xor(s, 32);
                rstd[ai][m] = rsqrtf(s * (1.f / D) + EPS); }
#pragma unroll
        for (int bj = 0; bj < 2; ++bj) {
            if constexpr (LAST) {
                const f32x4 w0 = *(const f32x4*)(mod + col0 + bj * HALF), w1 = *(const f32x4*)(mod + col0 + bj * HALF + 4);
                float* op = OUT + (size_t)row0 * D + col0 + bj * HALF;
#pragma unroll
                for (int ai = 0; ai < 2; ++ai)
#pragma unroll
                    for (int m = 0; m < 4; ++m) { const float r = rstd[ai][m];
                        *(f32x4*)(op + (size_t)(ai * HALF + m * 16) * D) = acc[ai][bj][m][0] * r * w0; *(f32x4*)(op + (size_t)(ai * HALF + m * 16) * D + 4) = acc[ai][bj][m][1] * r * w1; __builtin_amdgcn_sched_barrier(0); }
            } else {
                const float* mp = mod + (size_t)b * 3072 + col0 + bj * HALF;
                const f32x4 sh0 = *(const f32x4*)mp, sh1 = *(const f32x4*)(mp + 4), sc0 = *(const f32x4*)(mp + 1024) + 1.0f, sc1 = *(const f32x4*)(mp + 1028) + 1.0f;
#pragma unroll
                for (int ai = 0; ai < 2; ++ai)
#pragma unroll
                    for (int m = 0; m < 4; ++m) {
                        const f32x4 h0 = acc[ai][bj][m][0] * rstd[ai][m] * sc0 + sh0, h1 = acc[ai][bj][m][1] * rstd[ai][m] * sc1 + sh1;
                        u32x4 w; w.x = cvt_pk_bf16(h0[0], h0[1]); w.y = cvt_pk_bf16(h0[2], h0[3]); w.z = cvt_pk_bf16(h1[0], h1[1]); w.w = cvt_pk_bf16(h1[2], h1[3]);
                        *(u32x4*)(HN + (size_t)(row0 + ai * HALF + m * 16) * D + col0 + bj * HALF) = w;
                    }
            }
        }
    }
};
}
#define XB_TMO      128
#define XB_XCNT(j)  (256  + 64 * (j))
#define XB_XSUB(j)  (1280 + 64 * (j))
#define XB_XGEN(j)  (2304 + 64 * (j))
#define XB_TOP      3328
#define XB_TOPGEN   3392
#define XCD_BAR_WORDS 3456
#define XB_SPIN_CAP (1u << 18)

__device__ __forceinline__ unsigned xb_ld(unsigned* p)              { return __hip_atomic_load(p, __ATOMIC_RELAXED, __HIP_MEMORY_SCOPE_AGENT); }
__device__ __forceinline__ unsigned xb_add(unsigned* p, unsigned v) { return __hip_atomic_fetch_add(p, v, __ATOMIC_RELAXED, __HIP_MEMORY_SCOPE_AGENT); }
__device__ __forceinline__ unsigned xb_xcc_id() { return (unsigned)__builtin_amdgcn_s_getreg((3 << 11) | 20) & 0xFu; }
#define XB_SPIN(cond, bar) do { unsigned _sp = 0; while (cond) { __builtin_amdgcn_s_sleep(1); \
    if ((++_sp & 255u) == 0u) { if (xb_ld(&(bar)[XB_TMO])) break; if (_sp > XB_SPIN_CAP) { atomicAdd(&(bar)[XB_TMO], 1u); break; } } } } while (0)

struct XcdBarrier {
    unsigned* bar; unsigned x; unsigned w;
    volatile LAS unsigned* st;
};

__device__ __forceinline__ XcdBarrier xcd_barrier_post(unsigned* bar, volatile LAS unsigned* st) {
    XcdBarrier b; b.bar = bar; b.x = xb_xcc_id(); b.st = st;
    if (threadIdx.x == 0) (void)xb_add(&bar[XB_XCNT(b.x)], 1u);
    b.w = (unsigned)__builtin_amdgcn_readfirstlane((int)(threadIdx.x >> 6));
    return b;
}
__device__ __forceinline__ void xcd_barrier_complete(unsigned* bar, unsigned x, unsigned& nloc, unsigned& nx) {
    const unsigned G = gridDim.x * gridDim.y * gridDim.z;
    unsigned sum, cnt, mine, sp = 0u;
    for (;;) {
        sum = 0u; cnt = 0u; mine = 0u;
#pragma unroll
        for (unsigned j = 0; j < 16; ++j) { const unsigned c = xb_ld(&bar[XB_XCNT(j)]); sum += c; cnt += (c > 0u) ? 1u : 0u; mine = (j == x) ? c : mine; }
        if (sum == G) break;
        __builtin_amdgcn_s_sleep(1);
        if ((++sp & 255u) == 0u) { if (xb_ld(&bar[XB_TMO])) break; if (sp > XB_SPIN_CAP) { atomicAdd(&bar[XB_TMO], 1u); break; } }
    }
    nloc = mine > 0u ? mine : 1u; nx = cnt > 0u ? cnt : 1u;
}

__device__ __forceinline__ void xcd_barrier(const XcdBarrier& b) {
    asm volatile("s_waitcnt vmcnt(0)" ::: "memory");
    __syncthreads();
    if (b.w == 0u && pg8::hw_lane() == 0) {
        unsigned* bar = b.bar;
        __builtin_amdgcn_s_waitcnt(0);
        unsigned nloc = b.st[0], nx = b.st[1];
        if (nloc == 0u) { xcd_barrier_complete(bar, b.x, nloc, nx); b.st[0] = nloc; b.st[1] = nx; }
        const unsigned old = xb_add(&bar[XB_XSUB(b.x)], 1u);
        const unsigned gen = old / nloc;
        if (old + 1u == (gen + 1u) * nloc) {
            __builtin_amdgcn_fence(__ATOMIC_RELEASE, "agent");
            asm volatile("s_waitcnt vmcnt(0)" ::: "memory");
            const unsigned og = xb_add(&bar[XB_TOP], 1u);
            const unsigned tg = og / nx;
            if (og + 1u == (tg + 1u) * nx) xb_add(&bar[XB_TOPGEN], 1u);
            else XB_SPIN(xb_ld(&bar[XB_TOPGEN]) == tg, bar);
            __builtin_amdgcn_fence(__ATOMIC_ACQUIRE, "agent");
            xb_add(&bar[XB_XGEN(b.x)], 1u);
            asm volatile("s_waitcnt vmcnt(0)" ::: "memory");
        } else {
            XB_SPIN(xb_ld(&bar[XB_XGEN(b.x)]) == gen, bar);
            __builtin_amdgcn_fence(__ATOMIC_ACQUIRE, "agent");
            asm volatile("s_waitcnt vmcnt(0)" ::: "memory");
        }
    }
    __syncthreads();
}
__device__ __forceinline__ int win_src_col(int c) { return c < 1024 ? c : (c < 3584 ? c + 16 : (c < 3600 ? c - 3584 + 1024 : -1)); }
__device__ __forceinline__ void p0_transpose_item(const float* W, int K, int Nsrc, int nblk, bool winmap, bf16* WT, LAS float* scr, int item, int lane) {
    const int kb = item / nblk, nb = item % nblk, k0 = 64 * kb, n0 = 32 * nb;
    const int kr = lane >> 3, c4 = 4 * (lane & 7); int sc = n0 + c4; if (winmap) sc = win_src_col(sc);
#pragma unroll
    for (int i = 0; i < 8; ++i) { const int kk = 8 * i + kr; const f32x4 v = sc >= 0 ? *(const f32x4*)(W + (size_t)(k0 + kk) * Nsrc + sc) : (f32x4){0.f, 0.f, 0.f, 0.f};
        LAS float* sp = scr + kk * 33 + c4; sp[0] = v.x; sp[1] = v.y; sp[2] = v.z; sp[3] = v.w; }
    LDS_WAIT(); asm volatile("" ::: "memory");
    const int c = lane & 7;
#pragma unroll
    for (int j = 0; j < 4; ++j) { const int n = (lane >> 3) + 8 * j; const LAS float* s = scr + (8 * c) * 33 + n;
        v4u o; o.x = pg8::cvt_pk_bf16(s[0 * 33], s[1 * 33]); o.y = pg8::cvt_pk_bf16(s[2 * 33], s[3 * 33]); o.z = pg8::cvt_pk_bf16(s[4 * 33], s[5 * 33]); o.w = pg8::cvt_pk_bf16(s[6 * 33], s[7 * 33]);
        *(GAS v4u*)(WT + (size_t)(n0 + n) * K + k0 + 8 * c) = o; }
    LDS_WAIT(); asm volatile("" ::: "memory");
}
__device__ __forceinline__ void p0_tr_load(const float* W, int Nsrc, int nblk, bool winmap, int item, int lane, f32x4 (&v)[8], const float* nwa, const float* nwb) {
    const int kb = item / nblk, nb = item % nblk, k0 = 64 * kb, n0 = 32 * nb;
    const int kr = lane >> 3, c4 = 4 * (lane & 7); int sc = n0 + c4; if (winmap) sc = win_src_col(sc);
#pragma unroll
    for (int i = 0; i < 8; ++i) { const int kk = 8 * i + kr; v[i] = sc >= 0 ? *(const f32x4*)(W + (size_t)(k0 + kk) * Nsrc + sc) : (f32x4){0.f, 0.f, 0.f, 0.f}; }
    if (!winmap) {
#pragma unroll
        for (int i = 0; i < 8; ++i) { const int k = k0 + 8 * i + kr; const float s_ = k < 512 ? nwa[k & 127] : (k < 768 ? nwb[(k - 512) & 63] : 1.0f); v[i] = v[i] * s_; }
    }
}
__device__ __forceinline__ void p0_tr_finish(const f32x4 (&v)[8], int K, int nblk, bf16* WT, LAS float* scr, int item, int lane) {
    const int kb = item / nblk, nb = item % nblk, k0 = 64 * kb, n0 = 32 * nb;
    const int kr = lane >> 3, c4 = 4 * (lane & 7);
#pragma unroll
    for (int i = 0; i < 8; ++i) { const int kk = 8 * i + kr; LAS float* sp = scr + kk * 33 + c4; sp[0] = v[i].x; sp[1] = v[i].y; sp[2] = v[i].z; sp[3] = v[i].w; }
    LDS_WAIT(); asm volatile("" ::: "memory");
    const int c = lane & 7;
#pragma unroll
    for (int j = 0; j < 4; ++j) { const int n = (lane >> 3) + 8 * j; const LAS float* s = scr + (8 * c) * 33 + n;
        v4u o; o.x = pg8::cvt_pk_bf16(s[0 * 33], s[1 * 33]); o.y = pg8::cvt_pk_bf16(s[2 * 33], s[3 * 33]); o.z = pg8::cvt_pk_bf16(s[4 * 33], s[5 * 33]); o.w = pg8::cvt_pk_bf16(s[6 * 33], s[7 * 33]);
        *(GAS v4u*)(WT + (size_t)(n0 + n) * K + k0 + 8 * c) = o; }
    LDS_WAIT(); asm volatile("" ::: "memory");
}
__device__ __forceinline__ void p0_ada_item(const float* c, const float* w_ada, const float* b_ada, float* ADA, LAS float* ldsf, int item, int tid, int wave, int lane) {
    const int l = item / 48, cg = item % 48;
    LAS float* cT = ldsf + wave * (128 * 32);
    { const int b = lane & 31, kh = lane >> 5;
#pragma unroll 16
      for (int i = 0; i < 64; ++i) { const int kk = 2 * i + kh; cT[kk * 32 + b] = silu_f(c[b * 1024 + 128 * wave + kk]); } }
    LDS_WAIT(); asm volatile("" ::: "memory");
    float acc[32];
#pragma unroll
    for (int b = 0; b < 32; ++b) acc[b] = 0.f;
    const float* wp = w_ada + ((size_t)l * 1024 + 128 * wave) * 3072 + cg * 64 + lane;
    float wc[32], wn[32];
#pragma unroll
    for (int j = 0; j < 32; ++j) wc[j] = wp[(size_t)j * 3072];
    for (int g = 0; g < 4; ++g) {
        if (g < 3) {
#pragma unroll
            for (int j = 0; j < 32; ++j) wn[j] = wp[(size_t)(32 * (g + 1) + j) * 3072];
        }
#pragma unroll
        for (int j = 0; j < 32; ++j) { const int kk = 32 * g + j; const float w = wc[j];
#pragma unroll
            for (int b4 = 0; b4 < 8; ++b4) { const f32x4 cv = *(const LAS f32x4*)(cT + kk * 32 + 4 * b4);
                acc[4 * b4] += cv.x * w; acc[4 * b4 + 1] += cv.y * w; acc[4 * b4 + 2] += cv.z * w; acc[4 * b4 + 3] += cv.w * w; } }
#pragma unroll
        for (int j = 0; j < 32; ++j) wc[j] = wn[j];
    }
    __syncthreads();
#pragma unroll
    for (int b = 0; b < 32; ++b) ldsf[(wave * 32 + b) * 64 + lane] = acc[b];
    __syncthreads();
#pragma unroll
    for (int j = 0; j < 4; ++j) { const int o = tid + 512 * j, b = o >> 6, col = o & 63; float s = b_ada[l * 3072 + cg * 64 + col];
#pragma unroll
        for (int w = 0; w < 8; ++w) s += ldsf[(w * 32 + b) * 64 + col];
        ADA[((size_t)l * 32 + b) * 3072 + cg * 64 + col] = s; }
    __syncthreads();
}
typedef float f32x2v_ __attribute__((ext_vector_type(2)));
typedef _Float16 half2_t __attribute__((ext_vector_type(2)));
__device__ __forceinline__ unsigned pk_h2(float a, float b) { f32x2v_ v = {a, b}; return __builtin_bit_cast(unsigned, __builtin_convertvector(v, half2_t)); }
__device__ __forceinline__ float h_lo(unsigned w) { return (float)__builtin_bit_cast(half2_t, w)[0]; }
__device__ __forceinline__ float h_hi(unsigned w) { return (float)__builtin_bit_cast(half2_t, w)[1]; }
template <bool FIRST, bool FINAL, bool XF32>
__device__ __forceinline__ void row_pass(const float* xsrc, const bf16* xbsrc, const bf16* Y, const float* gate_prev, const float* ada_l, const float* fw, float* outf, bf16* xbdst, bf16* HN, int gw, int NGW, int lane) {
    for (int m0 = 2 * gw; m0 < M; m0 += 2 * NGW) {
        f32x4 v[2][4]; float s[2];
#pragma unroll
        for (int r = 0; r < 2; ++r) {
            const int m = m0 + r; const int b = m >> 11;
            if (XF32) { const f32x4* xr = (const f32x4*)(xsrc + (size_t)m * D) + lane;
#pragma unroll
                for (int j = 0; j < 4; ++j) v[r][j] = xr[64 * j]; }
            else { const v2u* xr = (const v2u*)(xbsrc + (size_t)m * D) + lane;
#pragma unroll
                for (int j = 0; j < 4; ++j) { const v2u w = xr[64 * j]; v[r][j] = (f32x4){h_lo(w.x), h_hi(w.x), h_lo(w.y), h_hi(w.y)}; } }
            if (!FIRST) {
                const v2u* yr = (const v2u*)(Y + (size_t)m * D) + lane; const f32x4* gp = (const f32x4*)(gate_prev + (size_t)b * 3072) + lane;
#pragma unroll
                for (int j = 0; j < 4; ++j) { const v2u w = yr[64 * j]; const f32x4 g = gp[64 * j]; v[r][j] = v[r][j] + g * (f32x4){bflo(w.x), bfhi(w.x), bflo(w.y), bfhi(w.y)}; }
            }
        }
#pragma unroll
        for (int r = 0; r < 2; ++r) { float a = 0.f;
#pragma unroll
            for (int j = 0; j < 4; ++j) a += (v[r][j].x * v[r][j].x + v[r][j].y * v[r][j].y) + (v[r][j].z * v[r][j].z + v[r][j].w * v[r][j].w);
            s[r] = a; }
#pragma unroll
        for (int o = 1; o < 64; o <<= 1) { s[0] += __shfl_xor(s[0], o); s[1] += __shfl_xor(s[1], o); }
#pragma unroll
        for (int r = 0; r < 2; ++r) {
            const int m = m0 + r; const int b = m >> 11;
            const float rstd = rsqrtf(s[r] * (1.f / D) + EPS);
            if (FINAL) {
                f32x4* od = (f32x4*)(outf + (size_t)m * D) + lane;
#pragma unroll
                for (int j = 0; j < 4; ++j) od[64 * j] = v[r][j] * rstd * ((const f32x4*)fw)[lane + 64 * j];
            } else {
                if (!FIRST) { v2u* od = (v2u*)(xbdst + (size_t)m * D) + lane;
#pragma unroll
                    for (int j = 0; j < 4; ++j) { v2u w; w.x = pk_h2(v[r][j].x, v[r][j].y); w.y = pk_h2(v[r][j].z, v[r][j].w); od[64 * j] = w; } }
                const f32x4* sh = (const f32x4*)(ada_l + (size_t)b * 3072) + lane; const f32x4* sc = (const f32x4*)(ada_l + (size_t)b * 3072 + 1024) + lane;
                v2u* o8 = (v2u*)(HN + (size_t)m * D) + lane;
#pragma unroll
                for (int j = 0; j < 4; ++j) { const f32x4 h = v[r][j] * rstd * (sc[64 * j] + 1.0f) + sh[64 * j]; v2u w; w.x = pg8::cvt_pk_bf16(h.x, h.y); w.y = pg8::cvt_pk_bf16(h.z, h.w); o8[64 * j] = w; }
            }
        }
    }
}
template <int DV, bool GLA>
__device__ __forceinline__ void scan_unit_valu(LAS unsigned char* lds, int b, int h, const bf16* Qs, const bf16* Ks, const bf16* Gs, const bf16* Vs, const bf16* Gate, const bf16* LRA,
                                               const float* w2, const float* bg, const float* normw, bf16* O, int ocol0, int tid) {
    constexpr int TPC = 512 / DV, DPT = 64 / TPC, OP = DV + 4;
    LAS float* qs = (LAS float*)lds; LAS float* ks = qs + 4096; LAS float* es = ks + 4096; LAS float* vs = es + 4096; LAS float* ob = vs + 64 * DV; LAS float* w2s = ob + 64 * OP;
    const int v = tid / TPC, dq = tid % TPC, d0 = dq * DPT;
    float S[DPT];
#pragma unroll
    for (int i = 0; i < DPT; ++i) S[i] = 0.f;
    if (GLA) { for (int i = tid; i < 1024; i += NTHR) w2s[i] = w2[(i >> 6) * 256 + h * 64 + (i & 63)]; if (tid < 64) w2s[1024 + tid] = bg[h * 64 + tid]; }
    const int srow = tid >> 3, sseg = tid & 7;
    for (int c = 0; c < T / 64; ++c) {
        const size_t tok0 = (size_t)b * T + 64 * c;
        __syncthreads();
        {
            const size_t ro = (tok0 + srow) * 256 + h * 64 + 8 * sseg;
            const v4u qv = *(const v4u*)(Qs + ro), kv = *(const v4u*)(Ks + ro);
            LAS float* qd = qs + srow * 64 + 8 * sseg; LAS float* kd = ks + srow * 64 + 8 * sseg; LAS float* ed = es + srow * 64 + 8 * sseg;
            qd[0] = bflo(qv.x); qd[1] = bfhi(qv.x); qd[2] = bflo(qv.y); qd[3] = bfhi(qv.y); qd[4] = bflo(qv.z); qd[5] = bfhi(qv.z); qd[6] = bflo(qv.w); qd[7] = bfhi(qv.w);
            kd[0] = bflo(kv.x); kd[1] = bfhi(kv.x); kd[2] = bflo(kv.y); kd[3] = bfhi(kv.y); kd[4] = bflo(kv.z); kd[5] = bfhi(kv.z); kd[6] = bflo(kv.w); kd[7] = bfhi(kv.w);
            if (GLA) {
                const v4u l0 = *(const v4u*)(LRA + (tok0 + srow) * 16), l1 = *(const v4u*)(LRA + (tok0 + srow) * 16 + 8);
                const float lr[16] = {bflo(l0.x), bfhi(l0.x), bflo(l0.y), bfhi(l0.y), bflo(l0.z), bfhi(l0.z), bflo(l0.w), bfhi(l0.w), bflo(l1.x), bfhi(l1.x), bflo(l1.y), bfhi(l1.y), bflo(l1.z), bfhi(l1.z), bflo(l1.w), bfhi(l1.w)};
#pragma unroll
                for (int j = 0; j < 8; ++j) { float z = w2s[1024 + 8 * sseg + j];
#pragma unroll
                    for (int r = 0; r < 16; ++r) z += lr[r] * w2s[r * 64 + 8 * sseg + j];
                    ed[j] = ex2(-softplus2(-z * LOG2E) * (1.0f / 16.0f)); }
            } else {
                const v4u gv = *(const v4u*)(Gs + ro);
                ed[0] = ex2(bflo(gv.x)); ed[1] = ex2(bfhi(gv.x)); ed[2] = ex2(bflo(gv.y)); ed[3] = ex2(bfhi(gv.y)); ed[4] = ex2(bflo(gv.z)); ed[5] = ex2(bfhi(gv.z)); ed[6] = ex2(bflo(gv.w)); ed[7] = ex2(bfhi(gv.w));
            }
            constexpr int VPT = DV / 8;
            const size_t vo = (tok0 + srow) * (size_t)(4 * DV) + h * DV + VPT * sseg;
            LAS float* vd = vs + srow * DV + VPT * sseg;
#pragma unroll
            for (int q8 = 0; q8 < VPT / 8; ++q8) { const v4u vv = *(const v4u*)(Vs + vo + 8 * q8);
                vd[8 * q8 + 0] = bflo(vv.x); vd[8 * q8 + 1] = bfhi(vv.x); vd[8 * q8 + 2] = bflo(vv.y); vd[8 * q8 + 3] = bfhi(vv.y); vd[8 * q8 + 4] = bflo(vv.z); vd[8 * q8 + 5] = bfhi(vv.z); vd[8 * q8 + 6] = bflo(vv.w); vd[8 * q8 + 7] = bfhi(vv.w); }
        }
        __syncthreads();
        for (int tt = 0; tt < 64; ++tt) {
            const float vv = vs[tt * DV + v]; float a = 0.f;
#pragma unroll
            for (int i4 = 0; i4 < DPT / 4; ++i4) {
                const f32x4 q4 = *(const LAS f32x4*)(qs + tt * 64 + d0 + 4 * i4), k4 = *(const LAS f32x4*)(ks + tt * 64 + d0 + 4 * i4), e4 = *(const LAS f32x4*)(es + tt * 64 + d0 + 4 * i4);
#pragma unroll
                for (int j = 0; j < 4; ++j) { S[4 * i4 + j] = e4[j] * S[4 * i4 + j] + k4[j] * vv; a += q4[j] * S[4 * i4 + j]; }
            }
#pragma unroll
            for (int o = 1; o < TPC; o <<= 1) a += __shfl_xor(a, o);
            if (dq == 0) ob[tt * OP + v] = a;
        }
        __syncthreads();
        {
            constexpr int CPT = DV / 8;
            const LAS float* orow = ob + srow * OP + CPT * sseg; float x[CPT]; float ss = 0.f;
#pragma unroll
            for (int j = 0; j < CPT; ++j) { x[j] = orow[j]; ss += x[j] * x[j]; }
            ss += __shfl_xor(ss, 1); ss += __shfl_xor(ss, 2); ss += __shfl_xor(ss, 4);
            const float rstd = rsqrtf(ss * (1.0f / DV) + EPS);
            const size_t go = (tok0 + srow) * (size_t)(4 * DV) + h * DV + CPT * sseg;
            bf16* op = O + (tok0 + srow) * (size_t)D + ocol0 + h * DV + CPT * sseg;
#pragma unroll
            for (int q8 = 0; q8 < CPT / 8; ++q8) { const v4u gg = *(const v4u*)(Gate + go + 8 * q8); const float* nw = normw + CPT * sseg + 8 * q8;
                const float gt[8] = {bflo(gg.x), bfhi(gg.x), bflo(gg.y), bfhi(gg.y), bflo(gg.z), bfhi(gg.z), bflo(gg.w), bfhi(gg.w)}; float y[8];
#pragma unroll
                for (int j = 0; j < 8; ++j) y[j] = x[8 * q8 + j] * rstd * nw[j] * gt[j];
                v4u w; w.x = pk2(y[0], y[1]); w.y = pk2(y[2], y[3]); w.z = pk2(y[4], y[5]); w.w = pk2(y[6], y[7]); *(v4u*)(op + 8 * q8) = w; }
        }
    }
    __syncthreads();
}
__device__ __forceinline__ void sb_unit_valu(LAS unsigned char* lds, int b, int h, int qb, const bf16* QC, const bf16* KC, const bf16* VC, const bf16* GC, bf16* O, int tid, int wave) {
    LAS float* Ks = (LAS float*)lds; LAS float* Vs = Ks + 4096;
    const int t0 = qb * 512, t = t0 + tid; const size_t rowq = ((size_t)b * T + t) * 256 + h * 64;
    float q[64], o[64];
#pragma unroll
    for (int i = 0; i < 8; ++i) { const v4u w = *(const v4u*)(QC + rowq + 8 * i); q[8 * i] = bflo(w.x); q[8 * i + 1] = bfhi(w.x); q[8 * i + 2] = bflo(w.y); q[8 * i + 3] = bfhi(w.y); q[8 * i + 4] = bflo(w.z); q[8 * i + 5] = bfhi(w.z); q[8 * i + 6] = bflo(w.w); q[8 * i + 7] = bfhi(w.w); }
#pragma unroll
    for (int i = 0; i < 64; ++i) o[i] = 0.f;
    float carry = 0.f; int wdone = 0; const int wt_max = t0 + 64 * wave + 63; const int srow = tid >> 3, sseg = tid & 7;
    for (int kt = qb * 8 + 7; kt >= 0; --kt) {
        { volatile LAS unsigned* fl = (volatile LAS unsigned*)(lds + LDSCTL_OFF); if ((tid & 63) == 0) fl[wave] = (unsigned)wdone; __syncthreads();
          const unsigned all = fl[0] & fl[1] & fl[2] & fl[3] & fl[4] & fl[5] & fl[6] & fl[7]; if (all) break; }
        { const size_t ro = ((size_t)b * T + 64 * kt + srow) * 256 + h * 64 + 8 * sseg; const v4u kv = *(const v4u*)(KC + ro), vv = *(const v4u*)(VC + ro);
          LAS float* kd = Ks + srow * 64 + 8 * sseg; LAS float* vd = Vs + srow * 64 + 8 * sseg;
          kd[0] = bflo(kv.x); kd[1] = bfhi(kv.x); kd[2] = bflo(kv.y); kd[3] = bfhi(kv.y); kd[4] = bflo(kv.z); kd[5] = bfhi(kv.z); kd[6] = bflo(kv.w); kd[7] = bfhi(kv.w);
          vd[0] = bflo(vv.x); vd[1] = bfhi(vv.x); vd[2] = bflo(vv.y); vd[3] = bfhi(vv.y); vd[4] = bflo(vv.z); vd[5] = bfhi(vv.z); vd[6] = bflo(vv.w); vd[7] = bfhi(vv.w); }
        __syncthreads();
        if (!wdone && 64 * kt < wt_max) {
            const int jhi = min(63, wt_max - 1 - 64 * kt);
            for (int j = jhi; j >= 0; --j) {
                const int s = 64 * kt + j; float z = 0.f;
#pragma unroll
                for (int i = 0; i < 16; ++i) { const f32x4 k4 = *(const LAS f32x4*)(Ks + j * 64 + 4 * i); z += q[4 * i] * k4[0] + q[4 * i + 1] * k4[1] + q[4 * i + 2] * k4[2] + q[4 * i + 3] * k4[3]; }
                const float sp = softplus2(z); const bool valid = s < t;
                const float w = valid ? ex2(z - sp + carry) : 0.f;
                carry += valid ? -sp : 0.f;
#pragma unroll
                for (int i = 0; i < 16; ++i) { const f32x4 v4 = *(const LAS f32x4*)(Vs + j * 64 + 4 * i); o[4 * i] += w * v4[0]; o[4 * i + 1] += w * v4[1]; o[4 * i + 2] += w * v4[2]; o[4 * i + 3] += w * v4[3]; }
            }
            wdone = __all(carry < -150.f) ? 1 : 0;
        }
    }
    __syncthreads();
    bf16* op = O + ((size_t)b * T + t) * D + 768 + h * 64;
#pragma unroll
    for (int i = 0; i < 8; ++i) { const v4u gg = *(const v4u*)(GC + rowq + 8 * i); v4u w;
        w.x = pk2(o[8 * i] * bflo(gg.x), o[8 * i + 1] * bfhi(gg.x)); w.y = pk2(o[8 * i + 2] * bflo(gg.y), o[8 * i + 3] * bfhi(gg.y));
        w.z = pk2(o[8 * i + 4] * bflo(gg.z), o[8 * i + 5] * bfhi(gg.z)); w.w = pk2(o[8 * i + 6] * bflo(gg.w), o[8 * i + 7] * bfhi(gg.w)); *(v4u*)(op + 8 * i) = w; }
}
typedef short bf16x8_t __attribute__((ext_vector_type(8)));
typedef short v4i16_t __attribute__((ext_vector_type(4)));
typedef float f32x16 __attribute__((ext_vector_type(16)));
#define MFMA32(a, b, c) __builtin_amdgcn_mfma_f32_32x32x16_bf16((a), (b), (c), 0, 0, 0)
constexpr int SB_PITCH = 144, SB_NK = 384;
constexpr float SB_THR = 3.552713678800501e-15f;
__device__ __forceinline__ int crow16(int i, int hi) { return (i & 3) + 8 * (i >> 2) + 4 * hi; }
template <bool MASK>
__device__ __forceinline__ void sb_block(const f32x16& p, int key0, int row, int hi, float& carry, v4u& w0, v4u& w1) {
    float be[16], om[16];
#pragma unroll
    for (int i = 0; i < 16; ++i) {
        const float e = ex2(fminf(-p[i], 126.f)), r = rcpf_(1.0f + e);
        float bt = r, o1 = e * r;
        if (MASK) { const bool valid = (key0 + crow16(i, hi)) < row; bt = valid ? bt : 0.f; o1 = valid ? o1 : 1.f; }
        be[i] = bt; om[i] = o1;
    }
    float glo[4], ghi[4];
#pragma unroll
    for (int j = 0; j < 4; ++j) { const float g = (om[4 * j] * om[4 * j + 1]) * (om[4 * j + 2] * om[4 * j + 3]);
        const auto rr = __builtin_amdgcn_permlane32_swap(__float_as_uint(g), __float_as_uint(g), false, false); glo[j] = __uint_as_float(rr[0]); ghi[j] = __uint_as_float(rr[1]); }
    float run = carry, w[16];
#pragma unroll
    for (int j = 3; j >= 0; --j) {
        const float e1 = run; run *= ghi[j]; const float e0 = run; run *= glo[j];
        float bt = hi ? e1 : e0;
        w[4 * j + 3] = be[4 * j + 3] * bt; bt *= om[4 * j + 3];
        w[4 * j + 2] = be[4 * j + 2] * bt; bt *= om[4 * j + 2];
        w[4 * j + 1] = be[4 * j + 1] * bt; bt *= om[4 * j + 1];
        w[4 * j] = be[4 * j] * bt;
    }
    carry = run;
    w0.x = pg8::cvt_pk_bf16(w[0], w[1]); w0.y = pg8::cvt_pk_bf16(w[2], w[3]); w0.z = pg8::cvt_pk_bf16(w[4], w[5]); w0.w = pg8::cvt_pk_bf16(w[6], w[7]);
    w1.x = pg8::cvt_pk_bf16(w[8], w[9]); w1.y = pg8::cvt_pk_bf16(w[10], w[11]); w1.z = pg8::cvt_pk_bf16(w[12], w[13]); w1.w = pg8::cvt_pk_bf16(w[14], w[15]);
}
__device__ __forceinline__ bf16x8_t sb_vfrag(const LAS unsigned char* Vl, int rowbase, int s, int c, int lane) {
    const int hi = lane >> 5, blk = (lane >> 4) & 1, i16 = lane & 15;
    const LAS unsigned char* p = Vl + (rowbase + 16 * s + 4 * hi + (i16 >> 2)) * SB_PITCH + (32 * c + 16 * blk + 4 * (i16 & 3)) * 2;
    const v4i16_t lo = __builtin_amdgcn_ds_read_tr16_b64_v4i16((LAS v4i16_t*)p);
    const v4i16_t hh = __builtin_amdgcn_ds_read_tr16_b64_v4i16((LAS v4i16_t*)(p + 8 * SB_PITCH));
    return (bf16x8_t){lo[0], lo[1], lo[2], lo[3], hh[0], hh[1], hh[2], hh[3]};
}
template <bool MASK>
__device__ __forceinline__ bool sb_tile(const LAS unsigned char* Kl, const LAS unsigned char* Vl, int trow, int key0, int row, bool do_p1, const bf16x8_t (&qf)[4], f32x16& o0, f32x16& o1, float& carry, int lane) {
    const int r32 = lane & 31, hi = lane >> 5;
    f32x16 zero;
#pragma unroll
    for (int i = 0; i < 16; ++i) zero[i] = 0.f;
    if (do_p1) {
        f32x16 p = zero;
#pragma unroll
        for (int ks = 0; ks < 4; ++ks) { const bf16x8_t a = *(const LAS bf16x8_t*)(Kl + (trow + 32 + r32) * SB_PITCH + (16 * ks + 8 * hi) * 2); p = MFMA32(a, qf[ks], p); }
        v4u w0, w1; sb_block<MASK>(p, key0 + 32, row, hi, carry, w0, w1);
        const bf16x8_t a0 = __builtin_bit_cast(bf16x8_t, w0), a1 = __builtin_bit_cast(bf16x8_t, w1);
        o0 = MFMA32(a0, sb_vfrag(Vl, trow + 32, 0, 0, lane), o0); o1 = MFMA32(a0, sb_vfrag(Vl, trow + 32, 0, 1, lane), o1);
        o0 = MFMA32(a1, sb_vfrag(Vl, trow + 32, 1, 0, lane), o0); o1 = MFMA32(a1, sb_vfrag(Vl, trow + 32, 1, 1, lane), o1);
        if (__all(carry < SB_THR)) return true;
    }
    {
        f32x16 p = zero;
#pragma unroll
        for (int ks = 0; ks < 4; ++ks) { const bf16x8_t a = *(const LAS bf16x8_t*)(Kl + (trow + r32) * SB_PITCH + (16 * ks + 8 * hi) * 2); p = MFMA32(a, qf[ks], p); }
        v4u w0, w1; sb_block<MASK>(p, key0, row, hi, carry, w0, w1);
        const bf16x8_t a0 = __builtin_bit_cast(bf16x8_t, w0), a1 = __builtin_bit_cast(bf16x8_t, w1);
        o0 = MFMA32(a0, sb_vfrag(Vl, trow, 0, 0, lane), o0); o1 = MFMA32(a0, sb_vfrag(Vl, trow, 0, 1, lane), o1);
        o0 = MFMA32(a1, sb_vfrag(Vl, trow, 1, 0, lane), o0); o1 = MFMA32(a1, sb_vfrag(Vl, trow, 1, 1, lane), o1);
    }
    return __all(carry < SB_THR);
}
__device__ __forceinline__ void sb_unit_mfma(LAS unsigned char* lds, int b, int h, int qb, const bf16* QC, const bf16* KC, const bf16* VC, const bf16* GC, bf16* O, int tid, int wave) {
    const int lane = tid & 63, r32 = lane & 31, hi = lane >> 5;
    LAS unsigned char* Kl = lds; LAS unsigned char* Vl = lds + SB_NK * SB_PITCH;
    volatile LAS unsigned* fl = (volatile LAS unsigned*)(lds + LDSCTL_OFF);
    const int q0 = qb * 256, qw = q0 + 32 * wave, row = qw + r32;
    const size_t tokb = (size_t)b * T;
    bf16x8_t qf[4];
#pragma unroll
    for (int ks = 0; ks < 4; ++ks) qf[ks] = *(const bf16x8_t*)(QC + (tokb + row) * 256 + h * 64 + 16 * ks + 8 * hi);
    f32x16 o0, o1;
#pragma unroll
    for (int i = 0; i < 16; ++i) { o0[i] = 0.f; o1[i] = 0.f; }
    float carry = 1.0f; int done = 0;
    int hi_key = q0 + 256, lo_key = hi_key > SB_NK ? hi_key - SB_NK : 0;
    const int kmax = qw + 30, T0 = kmax >> 6;
    for (;;) {
        __syncthreads();
        const int nch = (hi_key - lo_key) * 8;
        for (int cidx = tid; cidx < nch; cidx += NTHR) { const int r = cidx >> 3, ch = cidx & 7; const size_t g = (tokb + lo_key + r) * 256 + h * 64 + 8 * ch;
            *(LAS v4u*)(Kl + r * SB_PITCH + ch * 16) = *(const v4u*)(KC + g); *(LAS v4u*)(Vl + r * SB_PITCH + ch * 16) = *(const v4u*)(VC + g); }
        __syncthreads();
        if (!done) {
            const int Ttop = min(T0, (hi_key - 1) >> 6), Tlo = lo_key >> 6;
            for (int Tt = Ttop; Tt >= Tlo; --Tt) {
                const int key0 = 64 * Tt, trow = key0 - lo_key;
                bool fin;
                if (key0 + 63 >= qw) fin = sb_tile<true>(Kl, Vl, trow, key0, row, key0 + 32 <= kmax, qf, o0, o1, carry, lane);
                else fin = sb_tile<false>(Kl, Vl, trow, key0, row, true, qf, o0, o1, carry, lane);
                if (fin) { done = 1; break; }
            }
        }
        if (lane == 0) fl[wave] = (unsigned)done;
        __syncthreads();
        const unsigned all = fl[0] & fl[1] & fl[2] & fl[3] & fl[4] & fl[5] & fl[6] & fl[7];
        if (all || lo_key == 0) break;
        hi_key = lo_key; lo_key = hi_key > SB_NK ? hi_key - SB_NK : 0;
    }
    {
        LAS float* stg = (LAS float*)(lds + wave * 8704);
#pragma unroll
        for (int i = 0; i < 16; ++i) { stg[crow16(i, hi) * 68 + r32] = o0[i]; stg[crow16(i, hi) * 68 + 32 + r32] = o1[i]; }
        asm volatile("s_waitcnt lgkmcnt(0)" ::: "memory");
        const int rw = lane >> 1, hf = lane & 1; const size_t rr = tokb + qw + rw;
        const bf16* gp = GC + rr * 256 + h * 64 + 32 * hf; bf16* op = O + rr * D + 768 + h * 64 + 32 * hf; const LAS float* sp = stg + rw * 68 + 32 * hf;
#pragma unroll
        for (int q8 = 0; q8 < 4; ++q8) {
            const v4u gg = *(const v4u*)(gp + 8 * q8); const f32x4 a = *(const LAS f32x4*)(sp + 8 * q8), b2 = *(const LAS f32x4*)(sp + 8 * q8 + 4);
            v4u w; w.x = pg8::cvt_pk_bf16(a[0] * bflo(gg.x), a[1] * bfhi(gg.x)); w.y = pg8::cvt_pk_bf16(a[2] * bflo(gg.y), a[3] * bfhi(gg.y));
            w.z = pg8::cvt_pk_bf16(b2[0] * bflo(gg.z), b2[1] * bfhi(gg.z)); w.w = pg8::cvt_pk_bf16(b2[2] * bflo(gg.w), b2[3] * bfhi(gg.w));
            *(v4u*)(op + 8 * q8) = w;
        }
    }
}

#define SB_BARRIER() do { asm volatile("s_waitcnt lgkmcnt(0)" ::: "memory"); __builtin_amdgcn_s_barrier(); asm volatile("" ::: "memory"); } while (0)
__device__ __forceinline__ void sb_units_pipe(LAS unsigned char* lds, int n_units, int u0, int ustride, int uskip, const bf16* QC, const bf16* KC, const bf16* VC, const bf16* GC, bf16* O, int tid, int wave) {
    int tl = tid; asm volatile("" : "+v"(tl));
    int lane = tl & 63, r32 = lane & 31, hi = lane >> 5;
    LAS unsigned char* Kl = lds; LAS unsigned char* Vl = lds + SB_NK * SB_PITCH;
    volatile LAS unsigned* fl = (volatile LAS unsigned*)(lds + LDSCTL_OFF);
    constexpr int NPRE = (SB_NK * 8 + NTHR - 1) / NTHR;
    v4u kpre[NPRE], vpre[NPRE]; bf16x8_t qpre[4];
#define SB_PREFETCH(u_) do { const int bh_ = (u_) & 127, qb_ = 7 - ((u_) >> 7), h_ = bh_ & 3; const size_t tb_ = (size_t)(bh_ >> 2) * T; \
        const int hk_ = qb_ * 256 + 256, lk_ = hk_ > SB_NK ? hk_ - SB_NK : 0, nch_ = (hk_ - lk_) * 8; \
        _Pragma("unroll") for (int j = 0; j < NPRE; ++j) { const int ci_ = tl + NTHR * j; if (ci_ < nch_) { const size_t g_ = (tb_ + lk_ + (ci_ >> 3)) * 256 + h_ * 64 + 8 * (ci_ & 7); kpre[j] = *(const v4u*)(KC + g_); vpre[j] = *(const v4u*)(VC + g_); } } \
        _Pragma("unroll") for (int ks = 0; ks < 4; ++ks) qpre[ks] = *(const bf16x8_t*)(QC + (tb_ + qb_ * 256 + 32 * wave + r32) * 256 + h_ * 64 + 16 * ks + 8 * hi); } while (0)
    if (n_units > 0) SB_PREFETCH(u0);
    for (int iu = 0; iu < n_units; ++iu) {
        tl = tid; asm volatile("" : "+v"(tl)); lane = tl & 63; r32 = lane & 31; hi = lane >> 5;
        const int u = u0 + ustride * iu + (iu ? uskip : 0), bh = u & 127, qb = 7 - (u >> 7), b = bh >> 2, h = bh & 3;
        const int q0 = qb * 256, qw = q0 + 32 * wave, row = qw + r32;
        const size_t tokb = (size_t)b * T;
        int hi_key = q0 + 256, lo_key = hi_key > SB_NK ? hi_key - SB_NK : 0;
        SB_BARRIER();
        { const int nch = (hi_key - lo_key) * 8;
#pragma unroll
          for (int j = 0; j < NPRE; ++j) { const int ci = tl + NTHR * j; if (ci < nch) { *(LAS v4u*)(Kl + (ci >> 3) * SB_PITCH + (ci & 7) * 16) = kpre[j]; *(LAS v4u*)(Vl + (ci >> 3) * SB_PITCH + (ci & 7) * 16) = vpre[j]; } } }
        bf16x8_t qf[4]; v4u gate[4];
#pragma unroll
        for (int ks = 0; ks < 4; ++ks) { qf[ks] = qpre[ks]; gate[ks] = *(const v4u*)(GC + (tokb + qw + (lane >> 1)) * 256 + h * 64 + 32 * (lane & 1) + 8 * ks); }
        SB_BARRIER();
        if (iu + 1 < n_units) SB_PREFETCH(u0 + ustride * (iu + 1) + uskip);
        f32x16 o0, o1;
#pragma unroll
        for (int i = 0; i < 16; ++i) { o0[i] = 0.f; o1[i] = 0.f; }
        float carry = 1.0f; int done = 0;
        const int kmax = qw + 30, T0 = kmax >> 6;
        for (bool first = true;; first = false) {
            if (!first) {
                SB_BARRIER();
                const int nch = (hi_key - lo_key) * 8;
                for (int cidx = tl; cidx < nch; cidx += NTHR) { const int r = cidx >> 3, ch = cidx & 7; const size_t g = (tokb + lo_key + r) * 256 + h * 64 + 8 * ch;
                    *(LAS v4u*)(Kl + r * SB_PITCH + ch * 16) = *(const v4u*)(KC + g); *(LAS v4u*)(Vl + r * SB_PITCH + ch * 16) = *(const v4u*)(VC + g); }
                SB_BARRIER();
            }
            if (!done) {
                const int Ttop = min(T0, (hi_key - 1) >> 6), Tlo = lo_key >> 6;
                for (int Tt = Ttop; Tt >= Tlo; --Tt) {
                    const int key0 = 64 * Tt, trow = key0 - lo_key;
                    bool fin;
                    if (key0 + 63 >= qw) fin = sb_tile<true>(Kl, Vl, trow, key0, row, key0 + 32 <= kmax, qf, o0, o1, carry, lane);
                    else fin = sb_tile<false>(Kl, Vl, trow, key0, row, true, qf, o0, o1, carry, lane);
                    if (fin) { done = 1; break; }
                }
            }
            if (lane == 0) fl[wave] = (unsigned)done;
            SB_BARRIER();
            const unsigned all = fl[0] & fl[1] & fl[2] & fl[3] & fl[4] & fl[5] & fl[6] & fl[7];
            if (all || lo_key == 0) break;
            hi_key = lo_key; lo_key = hi_key > SB_NK ? hi_key - SB_NK : 0;
        }
        {
            LAS float* stg = (LAS float*)(lds + wave * 8704);
#pragma unroll
            for (int i = 0; i < 16; ++i) { stg[crow16(i, hi) * 68 + r32] = o0[i]; stg[crow16(i, hi) * 68 + 32 + r32] = o1[i]; }
            asm volatile("s_waitcnt lgkmcnt(0)" ::: "memory");
            const int rw = lane >> 1, hf = lane & 1; const size_t rr = tokb + qw + rw;
            bf16* op = O + rr * D + 768 + h * 64 + 32 * hf; const LAS float* sp = stg + rw * 68 + 32 * hf;
#pragma unroll
            for (int q8 = 0; q8 < 4; ++q8) {
                const v4u gg = gate[q8]; const f32x4 a = *(const LAS f32x4*)(sp + 8 * q8), b2 = *(const LAS f32x4*)(sp + 8 * q8 + 4);
                v4u w; w.x = pg8::cvt_pk_bf16(a[0] * bflo(gg.x), a[1] * bfhi(gg.x)); w.y = pg8::cvt_pk_bf16(a[2] * bflo(gg.y), a[3] * bfhi(gg.y));
                w.z = pg8::cvt_pk_bf16(b2[0] * bflo(gg.z), b2[1] * bfhi(gg.z)); w.w = pg8::cvt_pk_bf16(b2[2] * bflo(gg.w), b2[3] * bfhi(gg.w));
                *(v4u*)(op + 8 * q8) = w;
            }
        }
    }
#undef SB_PREFETCH
}
constexpr int SC_P = 144;
template <int DV> struct ScanLds {
    static constexpr int VP = DV * 2 + 16, OP = DV + 4;
    static constexpr int QM = 0, KM = QM + 64 * SC_P, Q0 = KM + 64 * SC_P, KET = Q0 + 64 * SC_P, V = KET + 64 * SC_P, DEC = V + 64 * VP, GS = DEC + 256, OB = GS + 2048, END = OB + 64 * OP * 4;
};
__device__ __forceinline__ bf16x8_t tr_frag(const LAS unsigned char* base, int pitch, int row0, int col0, int lane) {
    const int blk = (lane >> 4) & 1, i16 = lane & 15;
    const LAS unsigned char* p = base + (row0 + (i16 >> 2)) * pitch + (col0 + 16 * blk + 4 * (i16 & 3)) * 2;
    const v4i16_t lo = __builtin_amdgcn_ds_read_tr16_b64_v4i16((LAS v4i16_t*)p);
    return (bf16x8_t){lo[0], lo[1], lo[2], lo[3], 0, 0, 0, 0};
}
__device__ __forceinline__ bf16x8_t tr_frag2(const LAS unsigned char* base, int pitch, int rowa, int rowb, int col0, int lane) {
    const int blk = (lane >> 4) & 1, i16 = lane & 15;
    const int co = (col0 + 16 * blk + 4 * (i16 & 3)) * 2;
    const v4i16_t lo = __builtin_amdgcn_ds_read_tr16_b64_v4i16((LAS v4i16_t*)(base + (rowa + (i16 >> 2)) * pitch + co));
    const v4i16_t hh = __builtin_amdgcn_ds_read_tr16_b64_v4i16((LAS v4i16_t*)(base + (rowb + (i16 >> 2)) * pitch + co));
    return (bf16x8_t){lo[0], lo[1], lo[2], lo[3], hh[0], hh[1], hh[2], hh[3]};
}
__device__ __forceinline__ bf16x8_t pack8(const f32x16& x, int s) {
    v4u w; w.x = pg8::cvt_pk_bf16(x[8 * s], x[8 * s + 1]); w.y = pg8::cvt_pk_bf16(x[8 * s + 2], x[8 * s + 3]); w.z = pg8::cvt_pk_bf16(x[8 * s + 4], x[8 * s + 5]); w.w = pg8::cvt_pk_bf16(x[8 * s + 6], x[8 * s + 7]);
    return __builtin_bit_cast(bf16x8_t, w);
}
#define LDS_BARRIER() do { asm volatile("s_waitcnt lgkmcnt(0)" ::: "memory"); __builtin_amdgcn_s_barrier(); asm volatile("" ::: "memory"); } while (0)
template <int DV, bool GLA>
__device__ __forceinline__ void scan_unit_mfma(LAS unsigned char* lds, int b, int h, const bf16* Qs, const bf16* Ks, const bf16* Gs, const bf16* Vs, const bf16* Gate, const bf16* LRA,
                                               const float* w2, const float* bg, const float* normw, bf16* O, int ocol0, int tid, int wave) {
    typedef ScanLds<DV> L;
    constexpr int G2OFF = L::END;
    constexpr int RQ = G2OFF + 16384, RK = RQ + 64 * SC_P, RG = RK + 64 * SC_P;
    static_assert(RG + 64 * SC_P <= RING_BYTES, "scan LDS");
    constexpr int VPT = DV / 8, CPT = DV / 8, NC = T / 64;
    const int lane = tid & 63, r32 = lane & 31, hi = lane >> 5;
    const int ti = wave >> 2, cb = wave & 3; const bool mma_on = (32 * cb < DV);
    LAS float* gsum = (LAS float*)(lds + L::GS); LAS float* dec = (LAS float*)(lds + L::DEC); LAS float* obuf = (LAS float*)(lds + L::OB); LAS float* g2 = (LAS float*)(lds + G2OFF);
    f32x16 S0, S1;
    float pmask[8];
#pragma unroll
    for (int w = 0; w < 8; ++w) pmask[w] = (w < wave) ? 1.0f : 0.0f;
    unsigned cmask[8];
#pragma unroll
    for (int j = 0; j < 8; ++j) cmask[j] = ((crow16(2 * j, hi) <= r32) ? 0x0000FFFFu : 0u) | ((crow16(2 * j + 1, hi) <= r32) ? 0xFFFF0000u : 0u);
#pragma unroll
    for (int i = 0; i < 16; ++i) { S0[i] = 0.f; S1[i] = 0.f; }
    const int srow = tid >> 3, sseg = tid & 7;
    const size_t tokb = (size_t)b * T;
    (void)normw;
    const int gm = (wave >> 1) & 1, gn = wave & 1;
    bf16x8_t w2f = {0, 0, 0, 0, 0, 0, 0, 0}; float gbias = 0.f, gbl2_ = 0.f; v4u lraR = {0u, 0u, 0u, 0u};
    f32x16 zero16;
#pragma unroll
    for (int i = 0; i < 16; ++i) zero16[i] = 0.f;
    if (GLA && wave < 4) {
        v4u w;
        const float* wp = w2 + (8 * hi) * 256 + h * 64 + 32 * gn + r32;
        w.x = pg8::cvt_pk_bf16(wp[0], wp[256]); w.y = pg8::cvt_pk_bf16(wp[512], wp[768]); w.z = pg8::cvt_pk_bf16(wp[1024], wp[1280]); w.w = pg8::cvt_pk_bf16(wp[1536], wp[1792]);
        w2f = __builtin_bit_cast(bf16x8_t, w); gbias = bg[h * 64 + 32 * gn + r32]; gbl2_ = gbias * (-LOG2E);
    }
#define SCAN_GATE_BLOCK(chunk) do {   \
        const f32x16 zz = MFMA32(__builtin_bit_cast(bf16x8_t, lraR), w2f, zero16); \
        _Pragma("unroll") for (int i = 0; i < 16; ++i) g2[(32 * gm + crow16(i, hi)) * 64 + 32 * gn + r32] = lg2(1.0f + ex2(fminf(__builtin_fmaf(zz[i], -LOG2E, gbl2_), 126.f))) * (-1.0f / 16.0f); } while (0)
#define SCAN_LRA_LOAD(chunk) do { lraR = *(const v4u*)(LRA + (tokb + 64 * (chunk) + 32 * gm + r32) * 16 + 8 * hi); } while (0)
    v4u qw_ = {0u, 0u, 0u, 0u}, kw_ = qw_, gw_ = qw_; v4u vraw[VPT / 8], gateR[CPT / 8];
#define SCAN_RAW_LOAD(chunk) do { const size_t t0_ = tokb + 64 * (chunk); \
        { const size_t o_ = (t0_ + srow) * 256 + h * 64 + 8 * sseg; qw_ = *(const v4u*)(Qs + o_); kw_ = *(const v4u*)(Ks + o_); if (!GLA) gw_ = *(const v4u*)(Gs + o_); } \
        _Pragma("unroll") for (int q8 = 0; q8 < VPT / 8; ++q8) vraw[q8] = *(const v4u*)(Vs + (t0_ + srow) * (size_t)(4 * DV) + h * DV + VPT * sseg + 8 * q8); } while (0)
#define SCAN_RAW_TO_LDS() do { *(LAS v4u*)(lds + RQ + srow * SC_P + 16 * sseg) = qw_; *(LAS v4u*)(lds + RK + srow * SC_P + 16 * sseg) = kw_; if (!GLA) *(LAS v4u*)(lds + RG + srow * SC_P + 16 * sseg) = gw_; } while (0)
#define SCAN_GATE_LOAD(chunk) do { _Pragma("unroll") for (int q8 = 0; q8 < CPT / 8; ++q8) gateR[q8] = *(const v4u*)(Gate + (tokb + 64 * (chunk) + srow) * (size_t)(4 * DV) + h * DV + CPT * sseg + 8 * q8); } while (0)
    __syncthreads();
    if (GLA && wave < 4) { SCAN_LRA_LOAD(0); SCAN_GATE_BLOCK(0); SCAN_LRA_LOAD(1); }
    SCAN_RAW_LOAD(0); SCAN_GATE_LOAD(0); SCAN_RAW_TO_LDS();
    { const size_t o_ = (tokb + 64 + srow) * 256 + h * 64 + 8 * sseg; qw_ = *(const v4u*)(Qs + o_); kw_ = *(const v4u*)(Ks + o_); if (!GLA) gw_ = *(const v4u*)(Gs + o_); }
    __syncthreads();
    for (int c = 0; c < NC; ++c) {
        const size_t tok0 = tokb + 64 * c;
        const int cn = c + 1 < NC ? c + 1 : NC - 1, cnn = c + 2 < NC ? c + 2 : NC - 1;
        float g[8];
#pragma unroll
        for (int i = 0; i < 8; ++i) g[i] = GLA ? g2[(8 * wave + i) * 64 + lane] : bflo((unsigned)*(const LAS bf16*)(lds + RG + (8 * wave + i) * SC_P + lane * 2));
#pragma unroll
        for (int i = 1; i < 8; ++i) g[i] += g[i - 1];
        gsum[wave * 64 + lane] = g[7];
#pragma unroll
        for (int q8 = 0; q8 < VPT / 8; ++q8) *(LAS v4u*)(lds + L::V + srow * L::VP + (VPT * sseg + 8 * q8) * 2) = vraw[q8];
        LDS_BARRIER();
        float off = 0.f, bmid, ball;
        {
            float gs_[8];
#pragma unroll
            for (int w = 0; w < 8; ++w) { gs_[w] = gsum[w * 64 + lane]; off = __builtin_fmaf(gs_[w], pmask[w], off); }
            bmid = (gs_[0] + gs_[1]) + (gs_[2] + gs_[3]); ball = bmid + ((gs_[4] + gs_[5]) + (gs_[6] + gs_[7]));
        }
        {
            const float ofs_ = off - bmid;
            float ke[8], q0v_[8]; const float cm_ = ex2(bmid), ca_ = ex2(ball - bmid);
#pragma unroll
            for (int i = 0; i < 8; ++i) {
                const int t = 8 * wave + i; const float qv = bflo((unsigned)*(const LAS bf16*)(lds + RQ + t * SC_P + lane * 2)), kv = bflo((unsigned)*(const LAS bf16*)(lds + RK + t * SC_P + lane * 2));
                const float xc = fminf(fmaxf(g[i] + ofs_, -100.f), 100.f); const float eq = ex2(xc), ek = ex2(-xc);
                const float qm_ = qv * eq, km_ = kv * ek;
                { const unsigned w2_ = pg8::cvt_pk_bf16(qm_, km_);
                  *(LAS unsigned short*)(lds + L::QM + t * SC_P + lane * 2) = (unsigned short)w2_;
                  *(LAS unsigned short*)(lds + L::KM + t * SC_P + lane * 2) = (unsigned short)(w2_ >> 16); }
                q0v_[i] = qm_ * cm_;
                ke[i] = km_ * ca_;
            }
#pragma unroll
            for (int i = 0; i < 8; i += 2) { const int t = 8 * wave + i; const unsigned w2_ = pg8::cvt_pk_bf16(q0v_[i], q0v_[i + 1]);
                *(LAS unsigned short*)(lds + L::Q0 + t * SC_P + lane * 2) = (unsigned short)w2_;
                *(LAS unsigned short*)(lds + L::Q0 + (t + 1) * SC_P + lane * 2) = (unsigned short)(w2_ >> 16); }
            v4u w; w.x = pg8::cvt_pk_bf16(ke[0], ke[1]); w.y = pg8::cvt_pk_bf16(ke[2], ke[3]); w.z = pg8::cvt_pk_bf16(ke[4], ke[5]); w.w = pg8::cvt_pk_bf16(ke[6], ke[7]);
            *(LAS v4u*)(lds + L::KET + lane * SC_P + 16 * wave) = w;
            if (wave == 0) dec[lane] = ex2(ball);
        }
        LDS_BARRIER();
        SCAN_RAW_TO_LDS();
        { const size_t o_ = (tokb + 64 * cnn + srow) * 256 + h * 64 + 8 * sseg; qw_ = *(const v4u*)(Qs + o_); kw_ = *(const v4u*)(Ks + o_); if (!GLA) gw_ = *(const v4u*)(Gs + o_); }
        _Pragma("unroll") for (int q8 = 0; q8 < VPT / 8; ++q8) vraw[q8] = *(const v4u*)(Vs + (tokb + 64 * cn + srow) * (size_t)(4 * DV) + h * DV + VPT * sseg + 8 * q8);
        if (GLA && wave < 4) { SCAN_GATE_BLOCK(cn); SCAN_LRA_LOAD(cnn); }
        if (mma_on) {
            f32x16 o;
#pragma unroll
            for (int i = 0; i < 16; ++i) o[i] = 0.f;
#pragma unroll
            for (int di = 0; di < 2; ++di)
#pragma unroll
                for (int s2 = 0; s2 < 2; ++s2) {
                    const LAS unsigned char* qp = lds + L::Q0 + (32 * ti + r32) * SC_P + (32 * di + 16 * s2 + 4 * hi) * 2;
                    const v2u a_lo = *(const LAS v2u*)qp, a_hi = *(const LAS v2u*)(qp + 16);
                    const v4u aw = {a_lo.x, a_lo.y, a_hi.x, a_hi.y};
                    o = MFMA32(__builtin_bit_cast(bf16x8_t, aw), pack8(di == 0 ? S0 : S1, s2), o);
                }
#pragma unroll
            for (int sj = 0; sj < 2; ++sj) {
                if (sj <= ti) {
                    f32x16 sc;
#pragma unroll
                    for (int i = 0; i < 16; ++i) sc[i] = 0.f;
#pragma unroll
                    for (int ks = 0; ks < 4; ++ks) {
                        const bf16x8_t a = *(const LAS bf16x8_t*)(lds + L::KM + (32 * sj + r32) * SC_P + (16 * ks + 8 * hi) * 2);
                        const bf16x8_t bq = *(const LAS bf16x8_t*)(lds + L::QM + (32 * ti + r32) * SC_P + (16 * ks + 8 * hi) * 2);
                        sc = MFMA32(a, bq, sc);
                    }
#pragma unroll
                    for (int s2 = 0; s2 < 2; ++s2) {
                        v4u pw_ = __builtin_bit_cast(v4u, pack8(sc, s2));
                        if (sj == ti) { pw_.x &= cmask[4 * s2]; pw_.y &= cmask[4 * s2 + 1]; pw_.z &= cmask[4 * s2 + 2]; pw_.w &= cmask[4 * s2 + 3]; }
                        o = MFMA32(__builtin_bit_cast(bf16x8_t, pw_), tr_frag2(lds + L::V, L::VP, 32 * sj + 16 * s2 + 4 * hi, 32 * sj + 16 * s2 + 8 + 4 * hi, 32 * cb, lane), o);
                    }
                }
            }
#pragma unroll
            for (int j4 = 0; j4 < 4; ++j4) {
                const f32x4 d0 = *(const LAS f32x4*)(dec + 8 * j4 + 4 * hi), d1 = *(const LAS f32x4*)(dec + 32 + 8 * j4 + 4 * hi);
#pragma unroll
                for (int e = 0; e < 4; ++e) { S0[4 * j4 + e] *= d0[e]; S1[4 * j4 + e] *= d1[e]; }
            }
#pragma unroll
            for (int ks = 0; ks < 4; ++ks) {
                const bf16x8_t vb = tr_frag2(lds + L::V, L::VP, 16 * ks + 8 * hi, 16 * ks + 8 * hi + 4, 32 * cb, lane);
                const bf16x8_t a0 = *(const LAS bf16x8_t*)(lds + L::KET + r32 * SC_P + (16 * ks + 8 * hi) * 2);
                const bf16x8_t a1 = *(const LAS bf16x8_t*)(lds + L::KET + (32 + r32) * SC_P + (16 * ks + 8 * hi) * 2);
                S0 = MFMA32(a0, vb, S0); S1 = MFMA32(a1, vb, S1);
            }
#pragma unroll
            for (int i = 0; i < 16; ++i) obuf[(32 * ti + crow16(i, hi)) * L::OP + 32 * cb + r32] = o[i];
        }
        LDS_BARRIER();
        {
            const LAS float* orow = obuf + srow * L::OP + CPT * sseg; float x[CPT]; float ss = 0.f;
#pragma unroll
            for (int j = 0; j < CPT; ++j) x[j] = orow[j];
            { float s0_ = 0.f, s1_ = 0.f;
#pragma unroll
              for (int j = 0; j < CPT; j += 2) { s0_ = __builtin_fmaf(x[j], x[j], s0_); s1_ = __builtin_fmaf(x[j + 1], x[j + 1], s1_); }
              ss = s0_ + s1_; }
            ss += __builtin_bit_cast(float, __builtin_amdgcn_update_dpp(0, __builtin_bit_cast(int, ss), 0xB1, 0xF, 0xF, true));
            ss += __builtin_bit_cast(float, __builtin_amdgcn_update_dpp(0, __builtin_bit_cast(int, ss), 0x4E, 0xF, 0xF, true));
            ss += __builtin_bit_cast(float, __builtin_amdgcn_update_dpp(0, __builtin_bit_cast(int, ss), 0x141, 0xF, 0xF, true));
            const float rstd = rsqrtf(ss * (1.0f / DV) + EPS);
            bf16* op = O + (tok0 + srow) * (size_t)D + ocol0 + h * DV + CPT * sseg;
#pragma unroll
            for (int q8 = 0; q8 < CPT / 8; ++q8) { const v4u gg = gateR[q8];
                const float gt[8] = {bflo(gg.x), bfhi(gg.x), bflo(gg.y), bfhi(gg.y), bflo(gg.z), bfhi(gg.z), bflo(gg.w), bfhi(gg.w)}; float y[8];
#pragma unroll
                for (int j = 0; j < 8; ++j) y[j] = x[8 * q8 + j] * rstd * gt[j];
                v4u w; w.x = pg8::cvt_pk_bf16(y[0], y[1]); w.y = pg8::cvt_pk_bf16(y[2], y[3]); w.z = pg8::cvt_pk_bf16(y[4], y[5]); w.w = pg8::cvt_pk_bf16(y[6], y[7]); *(v4u*)(op + 8 * q8) = w; }
            SCAN_GATE_LOAD(cn);
        }
    }
    __syncthreads();
#undef SCAN_GATE_BLOCK
#undef SCAN_LRA_LOAD
#undef SCAN_RAW_LOAD
#undef SCAN_RAW_TO_LDS
#undef SCAN_GATE_LOAD
}
struct RevOrder {
    pg8::StaticOrder S;
    __device__ __forceinline__ bool next(int i, pg8::Unit& u) const { return i < 4 && S.next(3 - i, u); }
    __device__ __forceinline__ void a_ready(const pg8::Unit&) const {}
    __device__ __forceinline__ void done(const pg8::Unit&) const {}
};
struct Args { const float* in[12]; float* out; unsigned char* ws; int ph_lo, ph_hi; };
__global__ void __launch_bounds__(NTHR, 2) fwd_kernel(Args args) {
    extern __shared__ __attribute__((aligned(16))) unsigned char lds_raw[];
    LAS unsigned char* lds = (LAS unsigned char*)lds_raw;
    volatile LAS unsigned* MISC = (volatile LAS unsigned*)(lds + MISC_OFF);
    const int tid = threadIdx.x, lane = tid & 63, wave = __builtin_amdgcn_readfirstlane(tid >> 6);
    const int G = gridDim.x, bx = blockIdx.x, vcu = (G % 8 == 0) ? (bx % 8) * (G / 8) + bx / 8 : bx;
    unsigned char* ws = args.ws;
    gu32* ctl = (gu32*)(ws + WS_CTL);
    const float* x_in = args.in[0]; const float* c_in = args.in[1]; const float* w_ada = args.in[2]; const float* b_ada = args.in[3]; const float* w_in = args.in[4];
    const float* w_g2 = args.in[5]; const float* b_g = args.in[6]; const float* gla_nw = args.in[7]; const float* lb_logits = args.in[8]; const float* hgrn_nw = args.in[9];
    const float* w_out = args.in[10]; const float* final_w = args.in[11];
    bf16* XB = (bf16*)(ws + WS_XB);
    float* ADA = (float*)(ws + WS_ADA); float* LB = (float*)(ws + WS_LB);
    bf16* WIN = (bf16*)(ws + WS_WIN); bf16* WOUT = (bf16*)(ws + WS_WOUT); bf16* HN = (bf16*)(ws + WS_HN); bf16* OB = (bf16*)(ws + WS_O);
    unsigned char* P = ws + WS_P;
    bf16* YB = (bf16*)(ws + WS_P);
    for (int u = tid; u < (LDS_BYTES - LDSCTL_OFF) / 4; u += NTHR) ((LAS unsigned*)(lds + LDSCTL_OFF))[u] = 0u;
    __syncthreads();
    XcdBarrier bar; bar.bar = (unsigned*)(ctl + CW_BAR); bar.x = 0; bar.w = (unsigned)wave; bar.st = nullptr;
    if (!MK_PER_PHASE) bar = xcd_barrier_post((unsigned*)(ctl + CW_BAR), MISC + 8);
    const int lo = args.ph_lo, hi = args.ph_hi;
#define IN(k) (lo <= (k) && (k) < hi)
#define SEAM(k) do { if (IN(k) && IN((k) + 1)) xcd_barrier(bar); } while (0)
    const int gw = vcu * NWAVES + wave, NGW = G * NWAVES;

#ifndef NO_P0
    if (IN(0)) {
        LAS float* scr = (LAS float*)(lds + wave * 16384);
        constexpr int I_IN = (D / 64) * (NIN / 32), I_OUT = (D / 64) * (D / 32), NIT = DEPTH * (I_IN + I_OUT);
#define P0_DEC(it_, W_, WT_, NS_, NB_, WM_, R_) const int l_##R_ = (it_) / (I_IN + I_OUT), R_##x = (it_) % (I_IN + I_OUT); const bool WM_ = R_##x < I_IN; \
            const float* W_ = WM_ ? w_in + (size_t)l_##R_ * D * DIN : w_out + (size_t)l_##R_ * D * D; bf16* WT_ = WM_ ? WIN + (size_t)l_##R_ * NIN * D : WOUT + (size_t)l_##R_ * D * D; \
            const int NS_ = WM_ ? DIN : D, NB_ = WM_ ? NIN / 32 : D / 32, R_ = WM_ ? R_##x : R_##x - I_IN;
        {
            f32x4 cur[8]; int it = gw;
            if (it < NIT) { P0_DEC(it, W0, T0_, NS0, NB0, WM0, r0); p0_tr_load(W0, NS0, NB0, WM0, r0, lane, cur, gla_nw + l_r0 * 128, hgrn_nw + l_r0 * 64); }
            while (it < NIT) {
                const int itn = it + NGW; f32x4 nxt[8];
                if (itn < NIT) { P0_DEC(itn, W1, T1_, NS1, NB1, WM1, r1); p0_tr_load(W1, NS1, NB1, WM1, r1, lane, nxt, gla_nw + l_r1 * 128, hgrn_nw + l_r1 * 64); }
                { P0_DEC(it, W2, T2_, NS2, NB2, WM2, r2); p0_tr_finish(cur, D, NB2, T2_, scr, r2, lane); }
#pragma unroll
                for (int i = 0; i < 8; ++i) cur[i] = nxt[i];
                it = itn;
            }
        }
#undef P0_DEC
        __syncthreads();
        for (int it = vcu; it < DEPTH * 48; it += G) p0_ada_item(c_in, w_ada, b_ada, ADA, (LAS float*)lds, it, tid, wave, lane);
        if (vcu == G - 1 && tid < 256) {
            float lg[4], mx = -INFINITY, sum = 0.f;
#pragma unroll
            for (int l = 0; l < 4; ++l) { lg[l] = lb_logits[l * 256 + tid]; mx = fmaxf(mx, lg[l]); }
#pragma unroll
            for (int l = 0; l < 4; ++l) { lg[l] = expf(lg[l] - mx); sum += lg[l]; }
            const float inv = 1.0f / sum; const float p1 = lg[1] * inv, p2 = lg[2] * inv, p3 = lg[3] * inv;
            LB[tid] = 0.f; LB[256 + tid] = p1; LB[512 + tid] = p1 + p2; LB[768 + tid] = p1 + p2 + p3;
        }
    }
#endif
    SEAM(0);
    if (IN(1)) { int t_ = wave * 64 + pg8::hw_lane(); asm volatile("" : "+v"(t_)); const int gw_ = vcu * NWAVES + __builtin_amdgcn_readfirstlane(t_ >> 6);
        row_pass<true, false, true>(x_in, XB, YB, ADA, ADA, final_w, args.out, XB, HN, gw_, NGW, t_ & 63); }
    SEAM(1);
    for (int l = 0; l < DEPTH; ++l) {
        const int pb = 1 + 3 * l;
        const float* ada_l = ADA + (size_t)l * 32 * 3072;
#ifndef NO_GA
        if (IN(pb + 1)) {
            pg8::Gemm g{HN, WIN + (size_t)l * NIN * D, M, NIN, D, wave}; pg8::StaticOrder S; S.init(M, NIN, G, bx);
            pg8::EpiIn E{P, LB + l * 256};
            pg8::gemm_phase<pg8::EpiIn, pg8::StaticOrder, true, true>(lds, g, S, E);
        }
#endif
        SEAM(pb + 1);
        if (IN(pb + 2)) {
            int tid_b = wave * 64 + pg8::hw_lane(); asm volatile("" : "+v"(tid_b)); const int wave_b = __builtin_amdgcn_readfirstlane(tid_b >> 6);
#ifndef NO_SCAN
            for (int u = vcu; u < 256; u += G) {
                const int b = (u & 127) >> 2, h = u & 3;
                if (u < 128) scan_unit_mfma<128, true>(lds, b, h, (const bf16*)(P + P_QA), (const bf16*)(P + P_KA), nullptr, (const bf16*)(P + P_VA), (const bf16*)(P + P_GA), (const bf16*)(P + P_LRA),
                                                       w_g2 + (size_t)l * 16 * 256, b_g + l * 256, gla_nw + l * 128, OB, 0, tid_b, wave_b);
                else scan_unit_mfma<64, false>(lds, b, h, (const bf16*)(P + P_QB), (const bf16*)(P + P_KB), (const bf16*)(P + P_GFB), (const bf16*)(P + P_IB), (const bf16*)(P + P_GB), nullptr,
                                               nullptr, nullptr, hgrn_nw + l * 64, OB, 512, tid_b, wave_b);
            }
#endif
#ifndef NO_SB
            const bool bal_ = (G == 256); const int sb_n = bal_ ? (vcu < 128 ? 3 : 5) : (1024 - vcu + G - 1) / G, sb_0 = bal_ ? (vcu < 128 ? vcu : 128 + (vcu - 128)) : vcu, sb_s = bal_ ? 128 : G, sb_k = (bal_ && vcu < 128) ? 640 : 0;
            sb_units_pipe(lds, sb_n, sb_0, sb_s, sb_k, (const bf16*)(P + P_QC), (const bf16*)(P + P_KC), (const bf16*)(P + P_VC), (const bf16*)(P + P_GC), OB, tid_b, wave_b);
#endif
        }
        SEAM(pb + 2);
#ifndef NO_GC
        if (IN(pb + 3)) {
            pg8::Gemm g{OB, WOUT + (size_t)l * D * D, M, D, D, wave}; RevOrder S; S.S.init(M, D, G, bx);
            float* part_l = (float*)(ws + WS_PART) + (size_t)l * M * 16; unsigned* cnt_l = (unsigned*)(ctl + CW_PANEL) + l * 256 * 16;
            if (l == 0) { pg8::EpiNorm<true, false> E{x_in, (pg8::bf16_t*)XB, ada_l + 2048, ada_l + 32 * 3072, (pg8::bf16_t*)HN, args.out, part_l, cnt_l}; pg8::gemm_phase<pg8::EpiNorm<true, false>, RevOrder, true, true>(lds, g, S, E); }
            else if (l < DEPTH - 1) { pg8::EpiNorm<false, false> E{x_in, (pg8::bf16_t*)XB, ada_l + 2048, ada_l + 32 * 3072, (pg8::bf16_t*)HN, args.out, part_l, cnt_l}; pg8::gemm_phase<pg8::EpiNorm<false, false>, RevOrder, true, true>(lds, g, S, E); }
            else { pg8::EpiNorm<false, true> E{x_in, (pg8::bf16_t*)XB, ada_l + 2048, final_w, (pg8::bf16_t*)HN, args.out, part_l, cnt_l}; pg8::gemm_phase<pg8::EpiNorm<false, true>, RevOrder, true, true>(lds, g, S, E); }
        }
#endif
        SEAM(pb + 3);
    }
#undef IN
#undef SEAM
}

extern "C" void kernel_launch(void* const* d_in, const int* in_sizes, int n_in, void* d_out, int out_size, void* d_ws, size_t ws_size, hipStream_t stream) {
    static int grid = 0;
    if (grid == 0) {
        if (n_in != 12 || in_sizes[0] != M * D || out_size != M * D || ws_size < WS_END) { fprintf(stderr, "kernel_launch: unexpected shapes / workspace (n_in %d, ws %zu < %zu)\n", n_in, ws_size, (size_t)WS_END); grid = -1; return; }
        int dev = 0, cus = 0, per_cu = 0;
        if (hipGetDevice(&dev) != hipSuccess || hipDeviceGetAttribute(&cus, hipDeviceAttributeMultiprocessorCount, dev) != hipSuccess) { grid = -1; return; }
        if (hipFuncSetAttribute((const void*)fwd_kernel, hipFuncAttributeMaxDynamicSharedMemorySize, LDS_BYTES) != hipSuccess) { fprintf(stderr, "kernel_launch: hipFuncSetAttribute failed\n"); grid = -1; return; }
        if (hipOccupancyMaxActiveBlocksPerMultiprocessor(&per_cu, (const void*)fwd_kernel, NTHR, LDS_BYTES) != hipSuccess || per_cu < 1) fprintf(stderr, "kernel_launch: occupancy query reports %d\n", per_cu);
        (void)hipGetLastError();
        grid = cus;
    }
    if (grid < 0) return;
    if (hipMemsetAsync((char*)d_ws + WS_CTL, 0, CTL_ZERO_BYTES, stream) != hipSuccess) return;
    Args a{};
    for (int i = 0; i < 12; ++i) a.in[i] = (const float*)d_in[i];
    a.out = (float*)d_out; a.ws = (unsigned char*)d_ws;
#if MK_PER_PHASE
    for (int p = 0; p < N_PHASES; ++p) { a.ph_lo = p; a.ph_hi = p + 1; hipLaunchKernelGGL(fwd_kernel, dim3(grid), dim3(NTHR), LDS_BYTES, stream, a); }
#else
    a.ph_lo = 0; a.ph_hi = N_PHASES; hipLaunchKernelGGL(fwd_kernel, dim3(grid), dim3(NTHR), LDS_BYTES, stream, a);
#endif
}
```

```cpp
#include <hip/hip_runtime.h>
#include <cstdio>
#include <cstdint>
namespace pg8 {
#define PG8_LAS __attribute__((address_space(3)))
typedef unsigned short bf16_t;
typedef short bf16x8 __attribute__((ext_vector_type(8)));
typedef float f32x4 __attribute__((ext_vector_type(4)));
typedef unsigned u32x4 __attribute__((ext_vector_type(4)));
constexpr int BM = 256, BK = 64, HALF = 128, HTB = HALF * BK * 2  , STAGE_BYTES = 8 * HTB, NXCD = 8, WGM = 8;

__host__ __device__ __forceinline__ int lds_byte(int r, int c) { const int st = (r >> 4) * 2 + (c >> 5), rr = r & 15, cc = c & 31, ob = rr * 64 + cc * 2; return st * 1024 + (ob ^ (((ob >> 9) & 1) << 5)); }
__host__ __device__ __forceinline__ void stage_rc(int b, int& R, int& C) { const int st = b / 1024, sb = b % 1024, swz = sb ^ (((sb >> 9) & 1) << 5); R = (st >> 1) * 16 + swz / 64; C = (st & 1) * 32 + (swz % 64) / 2; }
__host__ __device__ __forceinline__ int perm32(int rho) { const int n = rho >> 4, i = rho & 15; return 8 * (i >> 2) + 4 * n + (i & 3); }

struct Unit { int pm, pn; };
struct Gemm { const bf16_t* A; const bf16_t* Bt; int M, N, K, wv; };
__device__ __forceinline__ int hw_lane() { unsigned m = ~0u; asm volatile("" : "+s"(m)); return (int)__builtin_amdgcn_mbcnt_hi(m, __builtin_amdgcn_mbcnt_lo(m, 0u)); }

struct StaticOrder {
    int nM, nN, nwg, G, c;
    __host__ __device__ void init(int M, int N, int G_, int c_) { nM = M / BM; nN = N / BM; nwg = nM * nN; G = G_; c = c_; }
    __host__ __device__ bool next(int i, Unit& u) const {
        const long L = (long)i * G + c; if (L >= nwg) return false;
        int wgid = (int)L; { const int q = nwg / NXCD, r = nwg % NXCD, xcd = wgid % NXCD, off = wgid / NXCD; wgid = (xcd < r ? xcd * (q + 1) : r * (q + 1) + (xcd - r) * q) + off; }
        const int nig = WGM * nN, gid = wgid / nig, fm = gid * WGM, gsz = (nM - fm) < WGM ? (nM - fm) : WGM;
        u.pm = fm + ((wgid % nig) % gsz); u.pn = (wgid % nig) / gsz; return true;
    }
    __device__ __forceinline__ void a_ready(const Unit&) const {}
    __device__ __forceinline__ void done(const Unit&) const {}
};

typedef float f32x2_t __attribute__((ext_vector_type(2))); typedef __bf16 bf16x2_t __attribute__((ext_vector_type(2)));
__device__ __forceinline__ unsigned cvt_pk_bf16(float lo, float hi) { f32x2_t v = {lo, hi}; bf16x2_t b = __builtin_convertvector(v, bf16x2_t); return __builtin_bit_cast(unsigned, b); }
template <class Epi, class Sched, bool ALIGN_EPI = false, bool SP2 = false>
__device__ __forceinline__ void gemm_phase(PG8_LAS unsigned char* lds, const Gemm g, const Sched& S, const Epi& E) {
    int tid_ = g.wv * 64 + hw_lane(); asm volatile("" : "+v"(tid_));
    const int tid = tid_, wid = __builtin_amdgcn_readfirstlane(tid >> 6), lane = tid & 63, wr = wid >> 2, wc = wid & 3, fr = lane & 15, fq = lane >> 4;
    const int K = g.K, nt = K / BK;
    unsigned voffA[2], voffB[2];
#pragma unroll
    for (int i = 0; i < 2; ++i) { int R, C; stage_rc(tid * 16 + i * 8192, R, C); const int Rb = Epi::PERM ? ((R & ~31) + perm32(R & 31)) : R;
        voffA[i] = (unsigned)(R * K + C) * 2u; voffB[i] = (unsigned)(Rb * K + C) * 2u; }
    const size_t kstep = (size_t)(BK * 2);
    const size_t hstep = (size_t)HALF * K * 2;
    const size_t tstep = 2 * hstep;
    const unsigned ldsw = (unsigned)wid * 1024u;
    const int aoff = lds_byte(wr * 64 + fr, fq * 8), boff = lds_byte(wc * 32 + fr, fq * 8);
#define PG8_SA(b, h) (((b) * 2 + (h)) * HTB)
#define PG8_SB(b, h) ((4 + (b) * 2 + (h)) * HTB)
#define PG8_STAGE(bufoff, gbase, voff) do { _Pragma("unroll") for (int _i = 0; _i < 2; ++_i) \
        __builtin_amdgcn_global_load_lds((const unsigned*)((const char*)(gbase) + (voff)[_i]), (PG8_LAS unsigned*)(lds + (bufoff) + ldsw + _i * 8192), 16, 0, 0); } while (0)
#define PG8_LDA(dst, b, h) do { _Pragma("unroll") for (int m = 0; m < 4; ++m) _Pragma("unroll") for (int k = 0; k < 2; ++k) dst[m][k] = *(const PG8_LAS bf16x8*)(lds + PG8_SA(b, h) + aoff + m * 2048 + k * 1024); } while (0)
#define PG8_LDB(dst, b, h) do { _Pragma("unroll") for (int n = 0; n < 2; ++n) _Pragma("unroll") for (int k = 0; k < 2; ++k) dst[n][k] = *(const PG8_LAS bf16x8*)(lds + PG8_SB(b, h) + boff + n * 2048 + k * 1024); } while (0)
#define PG8_MMA(ai, bj, At, Bt) do { __builtin_amdgcn_s_setprio(1); _Pragma("unroll") for (int m = 0; m < 4; ++m) _Pragma("unroll") for (int n = 0; n < 2; ++n) _Pragma("unroll") for (int k = 0; k < 2; ++k) \
        acc[ai][bj][m][n] = __builtin_amdgcn_mfma_f32_16x16x32_bf16(Bt[n][k], At[m][k], acc[ai][bj][m][n], 0, 0, 0); __builtin_amdgcn_s_setprio(0); } while (0)
#define PG8_WAIT_V(n) asm volatile("s_waitcnt vmcnt(" #n ")" ::: "memory")
#define PG8_WAIT_L(n) asm volatile("s_waitcnt lgkmcnt(" #n ")" ::: "memory")
#define PG8_BAR __builtin_amdgcn_s_barrier()
#define PG8_SCHED __builtin_amdgcn_sched_barrier(0)
    Unit cur, nxt; int ui = 0;
    if (!S.next(0, cur)) return;
    f32x4 acc[2][2][4][2];
#pragma unroll
    for (int a = 0; a < 2; ++a)
#pragma unroll
        for (int b = 0; b < 2; ++b)
#pragma unroll
            for (int m = 0; m < 4; ++m)
#pragma unroll
                for (int n = 0; n < 2; ++n) acc[a][b][m][n] = (f32x4){0.f, 0.f, 0.f, 0.f};
    bf16x8 At[4][2], B0[2][2], B1[2][2];
    const char* cA = (const char*)g.A + (size_t)cur.pm * tstep; const char* cB = (const char*)g.Bt + (size_t)cur.pn * tstep;
    S.a_ready(cur);
    if constexpr (SP2) {
        PG8_STAGE(PG8_SB(0, 0), cB, voffB); PG8_STAGE(PG8_SB(0, 1), cB + hstep, voffB); PG8_STAGE(PG8_SA(0, 0), cA, voffA); PG8_STAGE(PG8_SA(0, 1), cA + hstep, voffA);
        if (wr == 1) PG8_BAR;
        PG8_WAIT_V(2); PG8_BAR;
        PG8_STAGE(PG8_SB(1, 0), cB + kstep, voffB); PG8_STAGE(PG8_SA(1, 0), cA + kstep, voffA); PG8_STAGE(PG8_SB(1, 1), cB + hstep + kstep, voffB);
        PG8_WAIT_V(6); PG8_BAR;
    } else {
        PG8_STAGE(PG8_SB(0, 0), cB, voffB); PG8_STAGE(PG8_SA(0, 0), cA, voffA); PG8_STAGE(PG8_SB(0, 1), cB + hstep, voffB); PG8_STAGE(PG8_SA(0, 1), cA + hstep, voffA);
        if (wr == 1) PG8_BAR;
        PG8_WAIT_V(4); PG8_BAR;
        PG8_STAGE(PG8_SB(1, 0), cB + kstep, voffB); PG8_STAGE(PG8_SA(1, 0), cA + kstep, voffA); PG8_STAGE(PG8_SB(1, 1), cB + hstep + kstep, voffB);
        PG8_WAIT_V(6); PG8_BAR;
    }
    for (;;) {
        const bool has_next = S.next(ui + 1, nxt);
        const char* nA = has_next ? (const char*)g.A + (size_t)nxt.pm * tstep : cA; const char* nB = has_next ? (const char*)g.Bt + (size_t)nxt.pn * tstep : cB;
        for (int t = 0; t < nt; t += 2) {
            const bool last = (t == nt - 2);
            const char* a1 = cA + (size_t)(t + 1) * kstep;
            const char* a2 = last ? nA : cA + (size_t)(t + 2) * kstep; const char* b2 = last ? nB : cB + (size_t)(t + 2) * kstep;
            const char* a3 = a2 + kstep; const char* b3 = b2 + kstep;
            if (last && has_next) S.a_ready(nxt);
            if constexpr (SP2) {
            PG8_LDB(B0, 0, 0); PG8_LDB(B1, 0, 1); PG8_SCHED; PG8_LDA(At, 0, 0); PG8_STAGE(PG8_SA(1, 1), a1 + hstep, voffA);
            PG8_WAIT_V(8); PG8_WAIT_L(0); PG8_BAR; PG8_MMA(0, 0, At, B0); PG8_MMA(0, 1, At, B1); PG8_BAR; PG8_SCHED;
            PG8_LDA(At, 0, 1); PG8_STAGE(PG8_SB(0, 0), b2, voffB); PG8_STAGE(PG8_SB(0, 1), b2 + hstep, voffB); PG8_STAGE(PG8_SA(0, 0), a2, voffA);
            PG8_WAIT_V(8); PG8_WAIT_L(0); PG8_BAR; PG8_MMA(1, 0, At, B0); PG8_MMA(1, 1, At, B1); PG8_BAR; PG8_SCHED;
            PG8_LDB(B0, 1, 0); PG8_LDB(B1, 1, 1); PG8_SCHED; PG8_LDA(At, 1, 0); PG8_STAGE(PG8_SA(0, 1), a2 + hstep, voffA);
            PG8_WAIT_V(8); PG8_WAIT_L(0); PG8_BAR; PG8_MMA(0, 0, At, B0); PG8_MMA(0, 1, At, B1); PG8_BAR; PG8_SCHED;
            PG8_LDA(At, 1, 1); PG8_STAGE(PG8_SB(1, 0), b3, voffB); PG8_STAGE(PG8_SB(1, 1), b3 + hstep, voffB); PG8_STAGE(PG8_SA(1, 0), a3, voffA);
            PG8_WAIT_V(8); PG8_WAIT_L(0); PG8_BAR; PG8_MMA(1, 0, At, B0); PG8_MMA(1, 1, At, B1); PG8_BAR; PG8_SCHED;
            } else {
            PG8_LDB(B0, 0, 0); PG8_SCHED; PG8_LDA(At, 0, 0); PG8_STAGE(PG8_SA(1, 1), a1 + hstep, voffA);
            PG8_WAIT_L(8); PG8_BAR; PG8_WAIT_L(0); PG8_MMA(0, 0, At, B0); PG8_BAR; PG8_SCHED;
            PG8_LDB(B1, 0, 1); PG8_STAGE(PG8_SB(0, 0), b2, voffB);
            PG8_BAR; PG8_WAIT_L(0); PG8_MMA(0, 1, At, B1); PG8_BAR;
            PG8_LDA(At, 0, 1); PG8_STAGE(PG8_SA(0, 0), a2, voffA);
            PG8_BAR; PG8_WAIT_L(0); PG8_MMA(1, 0, At, B0); PG8_BAR; PG8_SCHED;
            PG8_STAGE(PG8_SB(0, 1), b2 + hstep, voffB);
            PG8_WAIT_V(6); PG8_BAR; PG8_MMA(1, 1, At, B1); PG8_BAR;
            PG8_LDB(B0, 1, 0); PG8_SCHED; PG8_LDA(At, 1, 0); PG8_STAGE(PG8_SA(0, 1), a2 + hstep, voffA);
            PG8_WAIT_L(8); PG8_BAR; PG8_WAIT_L(0); PG8_MMA(0, 0, At, B0); PG8_BAR; PG8_SCHED;
            PG8_LDB(B1, 1, 1); PG8_STAGE(PG8_SB(1, 0), b3, voffB);
            PG8_BAR; PG8_WAIT_L(0); PG8_MMA(0, 1, At, B1); PG8_BAR;
            PG8_LDA(At, 1, 1); PG8_STAGE(PG8_SA(1, 0), a3, voffA);
            PG8_BAR; PG8_WAIT_L(0); PG8_MMA(1, 0, At, B0); PG8_BAR; PG8_SCHED;
            PG8_STAGE(PG8_SB(1, 1), b3 + hstep, voffB);
            PG8_WAIT_V(6); PG8_BAR; PG8_MMA(1, 1, At, B1); PG8_BAR;
            }
        }
        if constexpr (ALIGN_EPI) { if (wr == 0) PG8_BAR; }
        if constexpr (!Epi::AFTER_DRAIN) { E(acc, cur, wr, wc, fr, fq); S.done(cur); }
        if (!has_next) break;
#pragma unroll
        for (int a = 0; a < 2; ++a)
#pragma unroll
            for (int b = 0; b < 2; ++b)
#pragma unroll
                for (int m = 0; m < 4; ++m)
#pragma unroll
                    for (int n = 0; n < 2; ++n) acc[a][b][m][n] = (f32x4){0.f, 0.f, 0.f, 0.f};
        cur = nxt; cA = nA; cB = nB; ++ui;
        if constexpr (ALIGN_EPI) { if (wr == 1) PG8_BAR; }
    }
    PG8_WAIT_V(0);
    if constexpr (!ALIGN_EPI) { if (wr == 0) PG8_BAR; }
    PG8_BAR;
    if constexpr (Epi::AFTER_DRAIN) { E.fused(acc, cur, wr, wc, fr, fq, lds, wid, lane); S.done(cur); }
#undef PG8_SA
#undef PG8_SB
#undef PG8_STAGE
#undef PG8_LDA
#undef PG8_LDB
#undef PG8_MMA
#undef PG8_WAIT_V
#undef PG8_WAIT_L
#undef PG8_BAR
#undef PG8_SCHED
}
}
constexpr int NWAVES = 8, NTHR = 512;
constexpr int BATCH = 32, T = 2048, D = 1024, DEPTH = 4, M = BATCH * T;
constexpr int DIN = 3600, NIN = 3840;
constexpr float EPS = 1e-6f, LOG2E = 1.4426950408889634f;
#ifndef MK_PER_PHASE
#define MK_PER_PHASE 0
#endif
constexpr int N_PHASES = 2 + 3 * DEPTH;

constexpr size_t MiB = 1u << 20;
constexpr size_t WS_CTL = 0, CTL_ZERO_BYTES = 1 * MiB;
constexpr size_t WS_ADA = 2 * MiB;
constexpr size_t WS_LB = 3 * MiB + 512 * 1024;
constexpr size_t WS_WIN = 4 * MiB;
constexpr size_t WS_WOUT = 34 * MiB;
constexpr size_t WS_HN = 64 * MiB;
constexpr size_t WS_O = 192 * MiB;
constexpr size_t WS_P = 320 * MiB;
constexpr size_t P_QA = 0, P_KA = 32 * MiB, P_VA = 64 * MiB, P_GA = 128 * MiB, P_QB = 192 * MiB, P_GFB = 224 * MiB, P_KB = 256 * MiB, P_IB = 288 * MiB,
                 P_GB = 320 * MiB, P_QC = 352 * MiB, P_KC = 384 * MiB, P_VC = 416 * MiB, P_GC = 448 * MiB, P_LRA = 480 * MiB;
constexpr size_t WS_XB = WS_P + 482 * MiB;
constexpr size_t WS_PART = WS_XB + 128 * MiB;
constexpr size_t WS_END = WS_PART + 16 * MiB;
constexpr int CW_PANEL = 16384;
constexpr int CW_TMO = 0, CW_CODE = 1, CW_BAR = 4096;

constexpr int RING_BYTES = 139264, LDSCTL_OFF = RING_BYTES, MISC_OFF = LDSCTL_OFF + 320, LDS_BYTES = 147456;

#define GAS __attribute__((address_space(1)))
#define LAS __attribute__((address_space(3)))
typedef unsigned short bf16;
typedef unsigned v4u __attribute__((ext_vector_type(4)));
typedef unsigned v2u __attribute__((ext_vector_type(2)));
typedef float f32x4 __attribute__((ext_vector_type(4)));
typedef GAS unsigned gu32;
#define RLX_AGENT __ATOMIC_RELAXED, __HIP_MEMORY_SCOPE_AGENT
#define LDS_WAIT() asm volatile("s_waitcnt lgkmcnt(0)" ::: "memory")
__device__ __forceinline__ unsigned f2bf(float f) { unsigned u = __builtin_bit_cast(unsigned, f); return (u + 0x7fffu + ((u >> 16) & 1u)) >> 16; }
__device__ __forceinline__ unsigned pk2(float lo, float hi) { return f2bf(lo) | (f2bf(hi) << 16); }
__device__ __forceinline__ float bflo(unsigned w) { return __uint_as_float(w << 16); }
__device__ __forceinline__ float bfhi(unsigned w) { return __uint_as_float(w & 0xffff0000u); }
__device__ __forceinline__ float ex2(float x) { return __builtin_amdgcn_exp2f(x); }
__device__ __forceinline__ float lg2(float x) { return __builtin_amdgcn_logf(x); }
__device__ __forceinline__ float rcpf_(float x) { return __builtin_amdgcn_rcpf(x); }
__device__ __forceinline__ float silu_f(float x) { return x * rcpf_(1.0f + ex2(-x * LOG2E)); }
__device__ __forceinline__ float softplus2(float z) { return fmaxf(z, 0.f) + lg2(1.0f + ex2(-fabsf(z))); }
__device__ __forceinline__ float wave_sum(float v) {
#pragma unroll
    for (int o = 1; o < 64; o <<= 1) v += __shfl_xor(v, o);
    return v;
}
namespace pg8 {
struct EpiIn {
    static constexpr bool PERM = true, AFTER_DRAIN = false;
    unsigned char* P;
    const float* lb;
    __device__ __forceinline__ void operator()(const f32x4 (&acc)[2][2][4][2], const Unit& u, int wr, int wc, int fr, int fq) const {
        const int pn = u.pn;
        size_t off; int ldc = 256, colt = 0, mode = 0; float scl = 1.f;
        if (pn == 0) { off = P_QA; scl = 0.125f; }
        else if (pn == 1) { off = P_KA; }
        else if (pn == 2) { off = P_VA; ldc = 512; }
        else if (pn == 3) { off = P_VA; ldc = 512; colt = 256; }
        else if (pn == 4) { off = P_GA; ldc = 512; mode = 2; }
        else if (pn == 5) { off = P_GA; ldc = 512; colt = 256; mode = 2; }
        else if (pn == 6) { off = P_QB; mode = 2; }
        else if (pn == 7) { off = P_GFB; mode = 3; }
        else if (pn == 8) { off = P_IB; }
        else if (pn == 9) { off = P_GB; mode = 2; }
        else if (pn == 10) { off = P_QC; scl = 0.125f * LOG2E; }
        else if (pn == 11) { off = P_KC; }
        else if (pn == 12) { off = P_VC; }
        else if (pn == 13) { off = P_GC; mode = 2; }
        else { off = P_LRA; ldc = 16; mode = 4; }
        bf16_t* base = (bf16_t*)(P + off);
        const int row0 = u.pm * BM + wr * 64 + fr, cl = wc * 32 + 8 * fq;
        if (mode == 3) {
            bf16_t* kbase = (bf16_t*)(P + P_KB);
#pragma unroll
            for (int bj = 0; bj < 2; ++bj) {
                const f32x4 l0 = *(const f32x4*)(lb + bj * HALF + cl), l1 = *(const f32x4*)(lb + bj * HALF + cl + 4);
                const float lbv[8] = {l0[0], l0[1], l0[2], l0[3], l1[0], l1[1], l1[2], l1[3]};
#pragma unroll
                for (int ai = 0; ai < 2; ++ai)
#pragma unroll
                    for (int m = 0; m < 4; ++m) {
                        const size_t o = (size_t)(row0 + ai * HALF + m * 16) * 256 + cl + bj * HALF;
                        const f32x4 v0 = acc[ai][bj][m][0], v1 = acc[ai][bj][m][1];
                        const float x[8] = {v0[0], v0[1], v0[2], v0[3], v1[0], v1[1], v1[2], v1[3]};
                        float g[8], kk[8];
#pragma unroll
                        for (int j = 0; j < 8; ++j) { const float s = rcpf_(1.0f + ex2(-x[j] * LOG2E)); const float f = lbv[j] + (1.0f - lbv[j]) * s; g[j] = fmaxf(lg2(f), -200.f); kk[j] = (1.0f - lbv[j]) * (1.0f - s); }
                        u32x4 w; w.x = cvt_pk_bf16(g[0], g[1]); w.y = cvt_pk_bf16(g[2], g[3]); w.z = cvt_pk_bf16(g[4], g[5]); w.w = cvt_pk_bf16(g[6], g[7]);
                        *(u32x4*)(base + o) = w;
                        w.x = cvt_pk_bf16(kk[0], kk[1]); w.y = cvt_pk_bf16(kk[2], kk[3]); w.z = cvt_pk_bf16(kk[4], kk[5]); w.w = cvt_pk_bf16(kk[6], kk[7]);
                        *(u32x4*)(kbase + o) = w;
                    }
            }
        } else if (mode == 4) {
            if (wc == 0 && fq < 2) {
#pragma unroll
                for (int ai = 0; ai < 2; ++ai)
#pragma unroll
                    for (int m = 0; m < 4; ++m) {
                        const f32x4 v0 = acc[ai][0][m][0], v1 = acc[ai][0][m][1];
                        u32x4 w; w.x = cvt_pk_bf16(v0[0], v0[1]); w.y = cvt_pk_bf16(v0[2], v0[3]); w.z = cvt_pk_bf16(v1[0], v1[1]); w.w = cvt_pk_bf16(v1[2], v1[3]);
                        *(u32x4*)(base + (size_t)(row0 + ai * HALF + m * 16) * 16 + 8 * fq) = w;
                    }
            }
        } else {
#pragma unroll
            for (int ai = 0; ai < 2; ++ai)
#pragma unroll
                for (int m = 0; m < 4; ++m) {
                    bf16_t* rowp = base + (size_t)(row0 + ai * HALF + m * 16) * ldc + colt + cl;
#pragma unroll
                    for (int bj = 0; bj < 2; ++bj) {
                        f32x4 v0 = acc[ai][bj][m][0], v1 = acc[ai][bj][m][1];
                        if (mode == 2) {
#pragma unroll
                            for (int j = 0; j < 4; ++j) { v0[j] = silu_f(v0[j]); v1[j] = silu_f(v1[j]); }
                        } else { v0 = v0 * scl; v1 = v1 * scl; }
                        u32x4 w; w.x = cvt_pk_bf16(v0[0], v0[1]); w.y = cvt_pk_bf16(v0[2], v0[3]); w.z = cvt_pk_bf16(v1[0], v1[1]); w.w = cvt_pk_bf16(v1[2], v1[3]);
                        *(u32x4*)(rowp + bj * HALF) = w;
                    }
                }
        }
    }
};
typedef _Float16 h2v_ __attribute__((ext_vector_type(2)));
typedef float f2v_ __attribute__((ext_vector_type(2)));
__device__ __forceinline__ unsigned pk_f16(float a, float b) { f2v_ v = {a, b}; return __builtin_bit_cast(unsigned, __builtin_convertvector(v, h2v_)); }
__device__ __forceinline__ float f16_lo(unsigned w) { return (float)__builtin_bit_cast(h2v_, w)[0]; }
__device__ __forceinline__ float f16_hi(unsigned w) { return (float)__builtin_bit_cast(h2v_, w)[1]; }
template <bool XF32, bool LAST>
struct EpiNorm {
    static constexpr bool PERM = true, AFTER_DRAIN = false;
    const float* X32;
    bf16_t* XB;
    const float* gate;
    const float* mod;
    bf16_t* HN; float* OUT;
    float* part;
    unsigned* cnt;
    __device__ __forceinline__ void operator()(f32x4 (&acc)[2][2][4][2], const Unit& u, int wr, int wc, int fr_, int fq_) const {
        int ln_ = fq_ * 16 + fr_; asm volatile("" : "+v"(ln_));
        const int fr = ln_ & 15, fq = ln_ >> 4;
        const int row0 = u.pm * BM + wr * 64 + fr, col0 = u.pn * BM + wc * 32 + 8 * fq, b = u.pm >> 3;
        float ss[2][4];
        {
            const float* gp = gate + (size_t)b * 3072 + col0;
            f32x4 g[2][2];
#pragma unroll
            for (int bj = 0; bj < 2; ++bj) { g[bj][0] = *(const f32x4*)(gp + bj * HALF); g[bj][1] = *(const f32x4*)(gp + bj * HALF + 4); }
#pragma unroll
            for (int ai = 0; ai < 2; ++ai) {
                if constexpr (XF32) {
#pragma unroll
                    for (int mh = 0; mh < 2; ++mh) {
                        f32x4 xo[2][2][2];
#pragma unroll
                        for (int m2 = 0; m2 < 2; ++m2)
#pragma unroll
                            for (int bj = 0; bj < 2; ++bj) { const float* xp = X32 + (size_t)(row0 + ai * HALF + (2 * mh + m2) * 16) * D + col0 + bj * HALF; xo[m2][bj][0] = *(const f32x4*)xp; xo[m2][bj][1] = *(const f32x4*)(xp + 4); }
#pragma unroll
                        for (int m2 = 0; m2 < 2; ++m2) { const int m = 2 * mh + m2; float s = 0.f;
#pragma unroll
                            for (int bj = 0; bj < 2; ++bj) {
                                const f32x4 v0 = xo[m2][bj][0] + g[bj][0] * acc[ai][bj][m][0], v1 = xo[m2][bj][1] + g[bj][1] * acc[ai][bj][m][1];
                                acc[ai][bj][m][0] = v0; acc[ai][bj][m][1] = v1;
                                s += (v0[0] * v0[0] + v0[1] * v0[1]) + (v0[2] * v0[2] + v0[3] * v0[3]) + (v1[0] * v1[0] + v1[1] * v1[1]) + (v1[2] * v1[2] + v1[3] * v1[3]);
                                if constexpr (!LAST) { u32x4 w; w.x = pk_f16(v0[0], v0[1]); w.y = pk_f16(v0[2], v0[3]); w.z = pk_f16(v1[0], v1[1]); w.w = pk_f16(v1[2], v1[3]);
                                    *(u32x4*)(XB + (size_t)(row0 + ai * HALF + m * 16) * D + col0 + bj * HALF) = w; }
                            }
                            ss[ai][m] = s; }
                    }
                } else {
                    u32x4 xo[4][2];
#pragma unroll
                    for (int m = 0; m < 4; ++m)
#pragma unroll
                        for (int bj = 0; bj < 2; ++bj) xo[m][bj] = *(const u32x4*)(XB + (size_t)(row0 + ai * HALF + m * 16) * D + col0 + bj * HALF);
#pragma unroll
                    for (int m = 0; m < 4; ++m) { float s = 0.f;
#pragma unroll
                        for (int bj = 0; bj < 2; ++bj) {
                            const u32x4 x = xo[m][bj];
                            const f32x4 x0 = {f16_lo(x.x), f16_hi(x.x), f16_lo(x.y), f16_hi(x.y)}, x1 = {f16_lo(x.z), f16_hi(x.z), f16_lo(x.w), f16_hi(x.w)};
                            const f32x4 v0 = x0 + g[bj][0] * acc[ai][bj][m][0], v1 = x1 + g[bj][1] * acc[ai][bj][m][1];
                            acc[ai][bj][m][0] = v0; acc[ai][bj][m][1] = v1;
                            s += (v0[0] * v0[0] + v0[1] * v0[1]) + (v0[2] * v0[2] + v0[3] * v0[3]) + (v1[0] * v1[0] + v1[1] * v1[1]) + (v1[2] * v1[2] + v1[3] * v1[3]);
                            if constexpr (!LAST) { u32x4 w; w.x = pk_f16(v0[0], v0[1]); w.y = pk_f16(v0[2], v0[3]); w.z = pk_f16(v1[0], v1[1]); w.w = pk_f16(v1[2], v1[3]);
                                *(u32x4*)(XB + (size_t)(row0 + ai * HALF + m * 16) * D + col0 + bj * HALF) = w; }
                        }
                        ss[ai][m] = s; }
                }
            }
        }
#pragma unroll
        for (int ai = 0; ai < 2; ++ai)
#pragma unroll
            for (int m = 0; m < 4; ++m) { float s = ss[ai][m]; s += __shfl_xor(s, 16); s += __shfl_xor(s, 32);
                if (fq == 0) __hip_atomic_store(part + (size_t)(row0 + ai * HALF + m * 16) * 16 + u.pn * 4 + wc, s, __ATOMIC_RELAXED, __HIP_MEMORY_SCOPE_AGENT); }
        asm volatile("s_waitcnt vmcnt(0)" ::: "memory");
        __syncthreads();
        if (wr == 0 && wc == 0 && fr == 0 && fq == 0) {
            unsigned* c = cnt + u.pm * 16;
            (void)__hip_atomic_fetch_add(c, 1u, __ATOMIC_RELAXED, __HIP_MEMORY_SCOPE_AGENT);
            unsigned sp = 0;
            while (__hip_atomic_load(c, __ATOMIC_RELAXED, __HIP_MEMORY_SCOPE_AGENT) < 4u) { __builtin_amdgcn_s_sleep(1); if (++sp > (1u << 22)) break; }
        }
        asm volatile("" ::: "memory");
        __syncthreads();
        float rstd[2][4];
#pragma unroll
        for (int ai = 0; ai < 2; ++ai)
#pragma unroll
            for (int m = 0; m < 4; ++m) { unsigned long long* p = (unsigned long long*)(part + (size_t)(row0 + ai * HALF + m * 16) * 16 + 4 * fq);
                const unsigned long long q0 = __hip_atomic_load(p, __ATOMIC_RELAXED, __HIP_MEMORY_SCOPE_AGENT), q1 = __hip_atomic_load(p + 1, __ATOMIC_RELAXED, __HIP_MEMORY_SCOPE_AGENT);
                float s = (__builtin_bit_cast(float, (unsigned)q0) + __builtin_bit_cast(float, (unsigned)(q0 >> 32))) + (__builtin_bit_cast(float, (unsigned)q1) + __builtin_bit_cast(float, (unsigned)(q1 >> 32)));
                s += __shfl_xor(s, 16); s += __shfl_xor(s, 32);
                rstd[ai][m] = rsqrtf(s * (1.f / D) + EPS); }
#pragma unroll
        for (int bj = 0; bj < 2; ++bj) {
            if constexpr (LAST) {
                const f32x4 w0 = *(const f32x4*)(mod + col0 + bj * HALF), w1 = *(const f32x4*)(mod + col0 + bj * HALF + 4);
                float* op = OUT + (size_t)row0 * D + col0 + bj * HALF;
#pragma unroll
                for (int ai = 0; ai < 2; ++ai)
#pragma unroll
                    for (int m = 0; m < 4; ++m) { const float r = rstd[ai][m];
                        *(f32x4*)(op + (size_t)(ai * HALF + m * 16) * D) = acc[ai][bj][m][0] * r * w0; *(f32x4*)(op + (size_t)(ai * HALF + m * 16) * D + 4) = acc[ai][bj][m][1] * r * w1; __builtin_amdgcn_sched_barrier(0); }
            } else {
                const float* mp = mod + (size_t)b * 3072 + col0 + bj * HALF;
                const f32x4 sh0 = *(const f32x4*)mp, sh1 = *(const f32x4*)(mp + 4), sc0 = *(const f32x4*)(mp + 1024) + 1.0f, sc1 = *(const f32x4*)(mp + 1028) + 1.0f;
#pragma unroll
                for (int ai = 0; ai < 2; ++ai)
#pragma unroll
                    for (int m = 0; m < 4; ++m) {
                        const f32x4 h0 = acc[ai][bj][m][0] * rstd[ai][m] * sc0 + sh0, h1 = acc[ai][bj][m][1] * rstd[ai][m] * sc1 + sh1;
                        u32x4 w; w.x = cvt_pk_bf16(h0[0], h0[1]); w.y = cvt_pk_bf16(h0[2], h0[3]); w.z = cvt_pk_bf16(h1[0], h1[1]); w.w = cvt_pk_bf16(h1[2], h1[3]);
                        *(u32x4*)(HN + (size_t)(row0 + ai * HALF + m * 16) * D + col0 + bj * HALF) = w;
                    }
            }
        }
    }
};
}
#define XB_TMO      128
#define XB_XCNT(j)  (256  + 64 * (j))
#define XB_XSUB(j)  (1280 + 64 * (j))
#define XB_XGEN(j)  (2304 + 64 * (j))
#define XB_TOP      3328
#define XB_TOPGEN   3392
#define XCD_BAR_WORDS 3456
#define XB_SPIN_CAP (1u << 18)

__device__ __forceinline__ unsigned xb_ld(unsigned* p)              { return __hip_atomic_load(p, __ATOMIC_RELAXED, __HIP_MEMORY_SCOPE_AGENT); }
__device__ __forceinline__ unsigned xb_add(unsigned* p, unsigned v) { return __hip_atomic_fetch_add(p, v, __ATOMIC_RELAXED, __HIP_MEMORY_SCOPE_AGENT); }
__device__ __forceinline__ unsigned xb_xcc_id() { return (unsigned)__builtin_amdgcn_s_getreg((3 << 11) | 20) & 0xFu; }
#define XB_SPIN(cond, bar) do { unsigned _sp = 0; while (cond) { __builtin_amdgcn_s_sleep(1); \
    if ((++_sp & 255u) == 0u) { if (xb_ld(&(bar)[XB_TMO])) break; if (_sp > XB_SPIN_CAP) { atomicAdd(&(bar)[XB_TMO], 1u); break; } } } } while (0)

struct XcdBarrier {
    unsigned* bar; unsigned x; unsigned w;
    volatile LAS unsigned* st;
};

__device__ __forceinline__ XcdBarrier xcd_barrier_post(unsigned* bar, volatile LAS unsigned* st) {
    XcdBarrier b; b.bar = bar; b.x = xb_xcc_id(); b.st = st;
    if (threadIdx.x == 0) (void)xb_add(&bar[XB_XCNT(b.x)], 1u);
    b.w = (unsigned)__builtin_amdgcn_readfirstlane((int)(threadIdx.x >> 6));
    return b;
}
__device__ __forceinline__ void xcd_barrier_complete(unsigned* bar, unsigned x, unsigned& nloc, unsigned& nx) {
    const unsigned G = gridDim.x * gridDim.y * gridDim.z;
    unsigned sum, cnt, mine, sp = 0u;
    for (;;) {
        sum = 0u; cnt = 0u; mine = 0u;
#pragma unroll
        for (unsigned j = 0; j < 16; ++j) { const unsigned c = xb_ld(&bar[XB_XCNT(j)]); sum += c; cnt += (c > 0u) ? 1u : 0u; mine = (j == x) ? c : mine; }
        if (sum == G) break;
        __builtin_amdgcn_s_sleep(1);
        if ((++sp & 255u) == 0u) { if (xb_ld(&bar[XB_TMO])) break; if (sp > XB_SPIN_CAP) { atomicAdd(&bar[XB_TMO], 1u); break; } }
    }
    nloc = mine > 0u ? mine : 1u; nx = cnt > 0u ? cnt : 1u;
}

__device__ __forceinline__ void xcd_barrier(const XcdBarrier& b) {
    asm volatile("s_waitcnt vmcnt(0)" ::: "memory");
    __syncthreads();
    if (b.w == 0u && pg8::hw_lane() == 0) {
        unsigned* bar = b.bar;
        __builtin_amdgcn_s_waitcnt(0);
        unsigned nloc = b.st[0], nx = b.st[1];
        if (nloc == 0u) { xcd_barrier_complete(bar, b.x, nloc, nx); b.st[0] = nloc; b.st[1] = nx; }
        const unsigned old = xb_add(&bar[XB_XSUB(b.x)], 1u);
        const unsigned gen = old / nloc;
        if (old + 1u == (gen + 1u) * nloc) {
            __builtin_amdgcn_fence(__ATOMIC_RELEASE, "agent");
            asm volatile("s_waitcnt vmcnt(0)" ::: "memory");
            const unsigned og = xb_add(&bar[XB_TOP], 1u);
            const unsigned tg = og / nx;
            if (og + 1u == (tg + 1u) * nx) xb_add(&bar[XB_TOPGEN], 1u);
            else XB_SPIN(xb_ld(&bar[XB_TOPGEN]) == tg, bar);
            __builtin_amdgcn_fence(__ATOMIC_ACQUIRE, "agent");
            xb_add(&bar[XB_XGEN(b.x)], 1u);
            asm volatile("s_waitcnt vmcnt(0)" ::: "memory");
        } else {
            XB_SPIN(xb_ld(&bar[XB_XGEN(b.x)]) == gen, bar);
            __builtin_amdgcn_fence(__ATOMIC_ACQUIRE, "agent");
            asm volatile("s_waitcnt vmcnt(0)" ::: "memory");
        }
    }
    __syncthreads();
}
__device__ __forceinline__ int win_src_col(int c) { return c < 1024 ? c : (c < 3584 ? c + 16 : (c < 3600 ? c - 3584 + 1024 : -1)); }
__device__ __forceinline__ void p0_transpose_item(const float* W, int K, int Nsrc, int nblk, bool winmap, bf16* WT, LAS float* scr, int item, int lane) {
    const int kb = item / nblk, nb = item % nblk, k0 = 64 * kb, n0 = 32 * nb;
    const int kr = lane >> 3, c4 = 4 * (lane & 7); int sc = n0 + c4; if (winmap) sc = win_src_col(sc);
#pragma unroll
    for (int i = 0; i < 8; ++i) { const int kk = 8 * i + kr; const f32x4 v = sc >= 0 ? *(const f32x4*)(W + (size_t)(k0 + kk) * Nsrc + sc) : (f32x4){0.f, 0.f, 0.f, 0.f};
        LAS float* sp = scr + kk * 33 + c4; sp[0] = v.x; sp[1] = v.y; sp[2] = v.z; sp[3] = v.w; }
    LDS_WAIT(); asm volatile("" ::: "memory");
    const int c = lane & 7;
#pragma unroll
    for (int j = 0; j < 4; ++j) { const int n = (lane >> 3) + 8 * j; const LAS float* s = scr + (8 * c) * 33 + n;
        v4u o; o.x = pg8::cvt_pk_bf16(s[0 * 33], s[1 * 33]); o.y = pg8::cvt_pk_bf16(s[2 * 33], s[3 * 33]); o.z = pg8::cvt_pk_bf16(s[4 * 33], s[5 * 33]); o.w = pg8::cvt_pk_bf16(s[6 * 33], s[7 * 33]);
        *(GAS v4u*)(WT + (size_t)(n0 + n) * K + k0 + 8 * c) = o; }
    LDS_WAIT(); asm volatile("" ::: "memory");
}
__device__ __forceinline__ void p0_tr_load(const float* W, int Nsrc, int nblk, bool winmap, int item, int lane, f32x4 (&v)[8], const float* nwa, const float* nwb) {
    const int kb = item / nblk, nb = item % nblk, k0 = 64 * kb, n0 = 32 * nb;
    const int kr = lane >> 3, c4 = 4 * (lane & 7); int sc = n0 + c4; if (winmap) sc = win_src_col(sc);
#pragma unroll
    for (int i = 0; i < 8; ++i) { const int kk = 8 * i + kr; v[i] = sc >= 0 ? *(const f32x4*)(W + (size_t)(k0 + kk) * Nsrc + sc) : (f32x4){0.f, 0.f, 0.f, 0.f}; }
    if (!winmap) {
#pragma unroll
        for (int i = 0; i < 8; ++i) { const int k = k0 + 8 * i + kr; const float s_ = k < 512 ? nwa[k & 127] : (k < 768 ? nwb[(k - 512) & 63] : 1.0f); v[i] = v[i] * s_; }
    }
}
__device__ __forceinline__ void p0_tr_finish(const f32x4 (&v)[8], int K, int nblk, bf16* WT, LAS float* scr, int item, int lane) {
    const int kb = item / nblk, nb = item % nblk, k0 = 64 * kb, n0 = 32 * nb;
    const int kr = lane >> 3, c4 = 4 * (lane & 7);
#pragma unroll
    for (int i = 0; i < 8; ++i) { const int kk = 8 * i + kr; LAS float* sp = scr + kk * 33 + c4; sp[0] = v[i].x; sp[1] = v[i].y; sp[2] = v[i].z; sp[3] = v[i].w; }
    LDS_WAIT(); asm volatile("" ::: "memory");
    const int c = lane & 7;
#pragma unroll
    for (int j = 0; j < 4; ++j) { const int n = (lane >> 3) + 8 * j; const LAS float* s = scr + (8 * c) * 33 + n;
        v4u o; o.x = pg8::cvt_pk_bf16(s[0 * 33], s[1 * 33]); o.y = pg8::cvt_pk_bf16(s[2 * 33], s[3 * 33]); o.z = pg8::cvt_pk_bf16(s[4 * 33], s[5 * 33]); o.w = pg8::cvt_pk_bf16(s[6 * 33], s[7 * 33]);
        *(GAS v4u*)(WT + (size_t)(n0 + n) * K + k0 + 8 * c) = o; }
    LDS_WAIT(); asm volatile("" ::: "memory");
}
__device__ __forceinline__ void p0_ada_item(const float* c, const float* w_ada, const float* b_ada, float* ADA, LAS float* ldsf, int item, int tid, int wave, int lane) {
    const int l = item / 48, cg = item % 48;
    LAS float* cT = ldsf + wave * (128 * 32);
    { const int b = lane & 31, kh = lane >> 5;
#pragma unroll 16
      for (int i = 0; i < 64; ++i) { const int kk = 2 * i + kh; cT[kk * 32 + b] = silu_f(c[b * 1024 + 128 * wave + kk]); } }
    LDS_WAIT(); asm volatile("" ::: "memory");
    float acc[32];
#pragma unroll
    for (int b = 0; b < 32; ++b) acc[b] = 0.f;
    const float* wp = w_ada + ((size_t)l * 1024 + 128 * wave) * 3072 + cg * 64 + lane;
    float wc[32], wn[32];
#pragma unroll
    for (int j = 0; j < 32; ++j) wc[j] = wp[(size_t)j * 3072];
    for (int g = 0; g < 4; ++g) {
        if (g < 3) {
#pragma unroll
            for (int j = 0; j < 32; ++j) wn[j] = wp[(size_t)(32 * (g + 1) + j) * 3072];
        }
#pragma unroll
        for (int j = 0; j < 32; ++j) { const int kk = 32 * g + j; const float w = wc[j];
#pragma unroll
            for (int b4 = 0; b4 < 8; ++b4) { const f32x4 cv = *(const LAS f32x4*)(cT + kk * 32 + 4 * b4);
                acc[4 * b4] += cv.x * w; acc[4 * b4 + 1] += cv.y * w; acc[4 * b4 + 2] += cv.z * w; acc[4 * b4 + 3] += cv.w * w; } }
#pragma unroll
        for (int j = 0; j < 32; ++j) wc[j] = wn[j];
    }
    __syncthreads();
#pragma unroll
    for (int b = 0; b < 32; ++b) ldsf[(wave * 32 + b) * 64 + lane] = acc[b];
    __syncthreads();
#pragma unroll
    for (int j = 0; j < 4; ++j) { const int o = tid + 512 * j, b = o >> 6, col = o & 63; float s = b_ada[l * 3072 + cg * 64 + col];
#pragma unroll
        for (int w = 0; w < 8; ++w) s += ldsf[(w * 32 + b) * 64 + col];
        ADA[((size_t)l * 32 + b) * 3072 + cg * 64 + col] = s; }
    __syncthreads();
}
typedef float f32x2v_ __attribute__((ext_vector_type(2)));
typedef _Float16 half2_t __attribute__((ext_vector_type(2)));
__device__ __forceinline__ unsigned pk_h2(float a, float b) { f32x2v_ v = {a, b}; return __builtin_bit_cast(unsigned, __builtin_convertvector(v, half2_t)); }
__device__ __forceinline__ float h_lo(unsigned w) { return (float)__builtin_bit_cast(half2_t, w)[0]; }
__device__ __forceinline__ float h_hi(unsigned w) { return (float)__builtin_bit_cast(half2_t, w)[1]; }
template <bool FIRST, bool FINAL, bool XF32>
__device__ __forceinline__ void row_pass(const float* xsrc, const bf16* xbsrc, const bf16* Y, const float* gate_prev, const float* ada_l, const float* fw, float* outf, bf16* xbdst, bf16* HN, int gw, int NGW, int lane) {
    for (int m0 = 2 * gw; m0 < M; m0 += 2 * NGW) {
        f32x4 v[2][4]; float s[2];
#pragma unroll
        for (int r = 0; r < 2; ++r) {
            const int m = m0 + r; const int b = m >> 11;
            if (XF32) { const f32x4* xr = (const f32x4*)(xsrc + (size_t)m * D) + lane;
#pragma unroll
                for (int j = 0; j < 4; ++j) v[r][j] = xr[64 * j]; }
            else { const v2u* xr = (const v2u*)(xbsrc + (size_t)m * D) + lane;
#pragma unroll
                for (int j = 0; j < 4; ++j) { const v2u w = xr[64 * j]; v[r][j] = (f32x4){h_lo(w.x), h_hi(w.x), h_lo(w.y), h_hi(w.y)}; } }
            if (!FIRST) {
                const v2u* yr = (const v2u*)(Y + (size_t)m * D) + lane; const f32x4* gp = (const f32x4*)(gate_prev + (size_t)b * 3072) + lane;
#pragma unroll
                for (int j = 0; j < 4; ++j) { const v2u w = yr[64 * j]; const f32x4 g = gp[64 * j]; v[r][j] = v[r][j] + g * (f32x4){bflo(w.x), bfhi(w.x), bflo(w.y), bfhi(w.y)}; }
            }
        }
#pragma unroll
        for (int r = 0; r < 2; ++r) { float a = 0.f;
#pragma unroll
            for (int j = 0; j < 4; ++j) a += (v[r][j].x * v[r][j].x + v[r][j].y * v[r][j].y) + (v[r][j].z * v[r][j].z + v[r][j].w * v[r][j].w);
            s[r] = a; }
#pragma unroll
        for (int o = 1; o < 64; o <<= 1) { s[0] += __shfl_xor(s[0], o); s[1] += __shfl_xor(s[1], o); }
#pragma unroll
        for (int r = 0; r < 2; ++r) {
            const int m = m0 + r; const int b = m >> 11;
            const float rstd = rsqrtf(s[r] * (1.f / D) + EPS);
            if (FINAL) {
                f32x4* od = (f32x4*)(outf + (size_t)m * D) + lane;
#pragma unroll
                for (int j = 0; j < 4; ++j) od[64 * j] = v[r][j] * rstd * ((const f32x4*)fw)[lane + 64 * j];
            } else {
                if (!FIRST) { v2u* od = (v2u*)(xbdst + (size_t)m * D) + lane;
#pragma unroll
                    for (int j = 0; j < 4; ++j) { v2u w; w.x = pk_h2(v[r][j].x, v[r][j].y); w.y = pk_h2(v[r][j].z, v[r][j].w); od[64 * j] = w; } }
                const f32x4* sh = (const f32x4*)(ada_l + (size_t)b * 3072) + lane; const f32x4* sc = (const f32x4*)(ada_l + (size_t)b * 3072 + 1024) + lane;
                v2u* o8 = (v2u*)(HN + (size_t)m * D) + lane;
#pragma unroll
                for (int j = 0; j < 4; ++j) { const f32x4 h = v[r][j] * rstd * (sc[64 * j] + 1.0f) + sh[64 * j]; v2u w; w.x = pg8::cvt_pk_bf16(h.x, h.y); w.y = pg8::cvt_pk_bf16(h.z, h.w); o8[64 * j] = w; }
            }
        }
    }
}
template <int DV, bool GLA>
__device__ __forceinline__ void scan_unit_valu(LAS unsigned char* lds, int b, int h, const bf16* Qs, const bf16* Ks, const bf16* Gs, const bf16* Vs, const bf16* Gate, const bf16* LRA,
                                               const float* w2, const float* bg, const float* normw, bf16* O, int ocol0, int tid) {
    constexpr int TPC = 512 / DV, DPT = 64 / TPC, OP = DV + 4;
    LAS float* qs = (LAS float*)lds; LAS float* ks = qs + 4096; LAS float* es = ks + 4096; LAS float* vs = es + 4096; LAS float* ob = vs + 64 * DV; LAS float* w2s = ob + 64 * OP;
    const int v = tid / TPC, dq = tid % TPC, d0 = dq * DPT;
    float S[DPT];
#pragma unroll
    for (int i = 0; i < DPT; ++i) S[i] = 0.f;
    if (GLA) { for (int i = tid; i < 1024; i += NTHR) w2s[i] = w2[(i >> 6) * 256 + h * 64 + (i & 63)]; if (tid < 64) w2s[1024 + tid] = bg[h * 64 + tid]; }
    const int srow = tid >> 3, sseg = tid & 7;
    for (int c = 0; c < T / 64; ++c) {
        const size_t tok0 = (size_t)b * T + 64 * c;
        __syncthreads();
        {
            const size_t ro = (tok0 + srow) * 256 + h * 64 + 8 * sseg;
            const v4u qv = *(const v4u*)(Qs + ro), kv = *(const v4u*)(Ks + ro);
            LAS float* qd = qs + srow * 64 + 8 * sseg; LAS float* kd = ks + srow * 64 + 8 * sseg; LAS float* ed = es + srow * 64 + 8 * sseg;
            qd[0] = bflo(qv.x); qd[1] = bfhi(qv.x); qd[2] = bflo(qv.y); qd[3] = bfhi(qv.y); qd[4] = bflo(qv.z); qd[5] = bfhi(qv.z); qd[6] = bflo(qv.w); qd[7] = bfhi(qv.w);
            kd[0] = bflo(kv.x); kd[1] = bfhi(kv.x); kd[2] = bflo(kv.y); kd[3] = bfhi(kv.y); kd[4] = bflo(kv.z); kd[5] = bfhi(kv.z); kd[6] = bflo(kv.w); kd[7] = bfhi(kv.w);
            if (GLA) {
                const v4u l0 = *(const v4u*)(LRA + (tok0 + srow) * 16), l1 = *(const v4u*)(LRA + (tok0 + srow) * 16 + 8);
                const float lr[16] = {bflo(l0.x), bfhi(l0.x), bflo(l0.y), bfhi(l0.y), bflo(l0.z), bfhi(l0.z), bflo(l0.w), bfhi(l0.w), bflo(l1.x), bfhi(l1.x), bflo(l1.y), bfhi(l1.y), bflo(l1.z), bfhi(l1.z), bflo(l1.w), bfhi(l1.w)};
#pragma unroll
                for (int j = 0; j < 8; ++j) { float z = w2s[1024 + 8 * sseg + j];
#pragma unroll
                    for (int r = 0; r < 16; ++r) z += lr[r] * w2s[r * 64 + 8 * sseg + j];
                    ed[j] = ex2(-softplus2(-z * LOG2E) * (1.0f / 16.0f)); }
            } else {
                const v4u gv = *(const v4u*)(Gs + ro);
                ed[0] = ex2(bflo(gv.x)); ed[1] = ex2(bfhi(gv.x)); ed[2] = ex2(bflo(gv.y)); ed[3] = ex2(bfhi(gv.y)); ed[4] = ex2(bflo(gv.z)); ed[5] = ex2(bfhi(gv.z)); ed[6] = ex2(bflo(gv.w)); ed[7] = ex2(bfhi(gv.w));
            }
            constexpr int VPT = DV / 8;
            const size_t vo = (tok0 + srow) * (size_t)(4 * DV) + h * DV + VPT * sseg;
            LAS float* vd = vs + srow * DV + VPT * sseg;
#pragma unroll
            for (int q8 = 0; q8 < VPT / 8; ++q8) { const v4u vv = *(const v4u*)(Vs + vo + 8 * q8);
                vd[8 * q8 + 0] = bflo(vv.x); vd[8 * q8 + 1] = bfhi(vv.x); vd[8 * q8 + 2] = bflo(vv.y); vd[8 * q8 + 3] = bfhi(vv.y); vd[8 * q8 + 4] = bflo(vv.z); vd[8 * q8 + 5] = bfhi(vv.z); vd[8 * q8 + 6] = bflo(vv.w); vd[8 * q8 + 7] = bfhi(vv.w); }
        }
        __syncthreads();
        for (int tt = 0; tt < 64; ++tt) {
            const float vv = vs[tt * DV + v]; float a = 0.f;
#pragma unroll
            for (int i4 = 0; i4 < DPT / 4; ++i4) {
                const f32x4 q4 = *(const LAS f32x4*)(qs + tt * 64 + d0 + 4 * i4), k4 = *(const LAS f32x4*)(ks + tt * 64 + d0 + 4 * i4), e4 = *(const LAS f32x4*)(es + tt * 64 + d0 + 4 * i4);
#pragma unroll
                for (int j = 0; j < 4; ++j) { S[4 * i4 + j] = e4[j] * S[4 * i4 + j] + k4[j] * vv; a += q4[j] * S[4 * i4 + j]; }
            }
#pragma unroll
            for (int o = 1; o < TPC; o <<= 1) a += __shfl_xor(a, o);
            if (dq == 0) ob[tt * OP + v] = a;
        }
        __syncthreads();
        {
            constexpr int CPT = DV / 8;
            const LAS float* orow = ob + srow * OP + CPT * sseg; float x[CPT]; float ss = 0.f;
#pragma unroll
            for (int j = 0; j < CPT; ++j) { x[j] = orow[j]; ss += x[j] * x[j]; }
            ss += __shfl_xor(ss, 1); ss += __shfl_xor(ss, 2); ss += __shfl_xor(ss, 4);
            const float rstd = rsqrtf(ss * (1.0f / DV) + EPS);
            const size_t go = (tok0 + srow) * (size_t)(4 * DV) + h * DV + CPT * sseg;
            bf16* op = O + (tok0 + srow) * (size_t)D + ocol0 + h * DV + CPT * sseg;
#pragma unroll
            for (int q8 = 0; q8 < CPT / 8; ++q8) { const v4u gg = *(const v4u*)(Gate + go + 8 * q8); const float* nw = normw + CPT * sseg + 8 * q8;
                const float gt[8] = {bflo(gg.x), bfhi(gg.x), bflo(gg.y), bfhi(gg.y), bflo(gg.z), bfhi(gg.z), bflo(gg.w), bfhi(gg.w)}; float y[8];
#pragma unroll
                for (int j = 0; j < 8; ++j) y[j] = x[8 * q8 + j] * rstd * nw[j] * gt[j];
                v4u w; w.x = pk2(y[0], y[1]); w.y = pk2(y[2], y[3]); w.z = pk2(y[4], y[5]); w.w = pk2(y[6], y[7]); *(v4u*)(op + 8 * q8) = w; }
        }
    }
    __syncthreads();
}
__device__ __forceinline__ void sb_unit_valu(LAS unsigned char* lds, int b, int h, int qb, const bf16* QC, const bf16* KC, const bf16* VC, const bf16* GC, bf16* O, int tid, int wave) {
    LAS float* Ks = (LAS float*)lds; LAS float* Vs = Ks + 4096;
    const int t0 = qb * 512, t = t0 + tid; const size_t rowq = ((size_t)b * T + t) * 256 + h * 64;
    float q[64], o[64];
#pragma unroll
    for (int i = 0; i < 8; ++i) { const v4u w = *(const v4u*)(QC + rowq + 8 * i); q[8 * i] = bflo(w.x); q[8 * i + 1] = bfhi(w.x); q[8 * i + 2] = bflo(w.y); q[8 * i + 3] = bfhi(w.y); q[8 * i + 4] = bflo(w.z); q[8 * i + 5] = bfhi(w.z); q[8 * i + 6] = bflo(w.w); q[8 * i + 7] = bfhi(w.w); }
#pragma unroll
    for (int i = 0; i < 64; ++i) o[i] = 0.f;
    float carry = 0.f; int wdone = 0; const int wt_max = t0 + 64 * wave + 63; const int srow = tid >> 3, sseg = tid & 7;
    for (int kt = qb * 8 + 7; kt >= 0; --kt) {
        { volatile LAS unsigned* fl = (volatile LAS unsigned*)(lds + LDSCTL_OFF); if ((tid & 63) == 0) fl[wave] = (unsigned)wdone; __syncthreads();
          const unsigned all = fl[0] & fl[1] & fl[2] & fl[3] & fl[4] & fl[5] & fl[6] & fl[7]; if (all) break; }
        { const size_t ro = ((size_t)b * T + 64 * kt + srow) * 256 + h * 64 + 8 * sseg; const v4u kv = *(const v4u*)(KC + ro), vv = *(const v4u*)(VC + ro);
          LAS float* kd = Ks + srow * 64 + 8 * sseg; LAS float* vd = Vs + srow * 64 + 8 * sseg;
          kd[0] = bflo(kv.x); kd[1] = bfhi(kv.x); kd[2] = bflo(kv.y); kd[3] = bfhi(kv.y); kd[4] = bflo(kv.z); kd[5] = bfhi(kv.z); kd[6] = bflo(kv.w); kd[7] = bfhi(kv.w);
          vd[0] = bflo(vv.x); vd[1] = bfhi(vv.x); vd[2] = bflo(vv.y); vd[3] = bfhi(vv.y); vd[4] = bflo(vv.z); vd[5] = bfhi(vv.z); vd[6] = bflo(vv.w); vd[7] = bfhi(vv.w); }
        __syncthreads();
        if (!wdone && 64 * kt < wt_max) {
            const int jhi = min(63, wt_max - 1 - 64 * kt);
            for (int j = jhi; j >= 0; --j) {
                const int s = 64 * kt + j; float z = 0.f;
#pragma unroll
                for (int i = 0; i < 16; ++i) { const f32x4 k4 = *(const LAS f32x4*)(Ks + j * 64 + 4 * i); z += q[4 * i] * k4[0] + q[4 * i + 1] * k4[1] + q[4 * i + 2] * k4[2] + q[4 * i + 3] * k4[3]; }
                const float sp = softplus2(z); const bool valid = s < t;
                const float w = valid ? ex2(z - sp + carry) : 0.f;
                carry += valid ? -sp : 0.f;
#pragma unroll
                for (int i = 0; i < 16; ++i) { const f32x4 v4 = *(const LAS f32x4*)(Vs + j * 64 + 4 * i); o[4 * i] += w * v4[0]; o[4 * i + 1] += w * v4[1]; o[4 * i + 2] += w * v4[2]; o[4 * i + 3] += w * v4[3]; }
            }
            wdone = __all(carry < -150.f) ? 1 : 0;
        }
    }
    __syncthreads();
    bf16* op = O + ((size_t)b * T + t) * D + 768 + h * 64;
#pragma unroll
    for (int i = 0; i < 8; ++i) { const v4u gg = *(const v4u*)(GC + rowq + 8 * i); v4u w;
        w.x = pk2(o[8 * i] * bflo(gg.x), o[8 * i + 1] * bfhi(gg.x)); w.y = pk2(o[8 * i + 2] * bflo(gg.y), o[8 * i + 3] * bfhi(gg.y));
        w.z = pk2(o[8 * i + 4] * bflo(gg.z), o[8 * i + 5] * bfhi(gg.z)); w.w = pk2(o[8 * i + 6] * bflo(gg.w), o[8 * i + 7] * bfhi(gg.w)); *(v4u*)(op + 8 * i) = w; }
}
typedef short bf16x8_t __attribute__((ext_vector_type(8)));
typedef short v4i16_t __attribute__((ext_vector_type(4)));
typedef float f32x16 __attribute__((ext_vector_type(16)));
#define MFMA32(a, b, c) __builtin_amdgcn_mfma_f32_32x32x16_bf16((a), (b), (c), 0, 0, 0)
constexpr int SB_PITCH = 144, SB_NK = 384;
constexpr float SB_THR = 3.552713678800501e-15f;
__device__ __forceinline__ int crow16(int i, int hi) { return (i & 3) + 8 * (i >> 2) + 4 * hi; }
template <bool MASK>
__device__ __forceinline__ void sb_block(const f32x16& p, int key0, int row, int hi, float& carry, v4u& w0, v4u& w1) {
    float be[16], om[16];
#pragma unroll
    for (int i = 0; i < 16; ++i) {
        float nz = -p[i];
        if (MASK) nz = ((key0 + crow16(i, hi)) < row) ? nz : __builtin_inff();
        const float e = ex2(__builtin_amdgcn_fmed3f(nz, -3.0e38f, 126.f)), r = rcpf_(1.0f + e);
        be[i] = r; om[i] = e * r;
    }
    float glo[4], ghi[4];
#pragma unroll
    for (int j = 0; j < 4; ++j) { const float g = (om[4 * j] * om[4 * j + 1]) * (om[4 * j + 2] * om[4 * j + 3]);
        const auto rr = __builtin_amdgcn_permlane32_swap(__float_as_uint(g), __float_as_uint(g), false, false); glo[j] = __uint_as_float(rr[0]); ghi[j] = __uint_as_float(rr[1]); }
    float run = carry, w[16];
#pragma unroll
    for (int j = 3; j >= 0; --j) {
        const float e1 = run; run *= ghi[j]; const float e0 = run; run *= glo[j];
        float bt = hi ? e1 : e0;
        w[4 * j + 3] = be[4 * j + 3] * bt; bt *= om[4 * j + 3];
        w[4 * j + 2] = be[4 * j + 2] * bt; bt *= om[4 * j + 2];
        w[4 * j + 1] = be[4 * j + 1] * bt; bt *= om[4 * j + 1];
        w[4 * j] = be[4 * j] * bt;
    }
    carry = run;
    w0.x = pg8::cvt_pk_bf16(w[0], w[1]); w0.y = pg8::cvt_pk_bf16(w[2], w[3]); w0.z = pg8::cvt_pk_bf16(w[4], w[5]); w0.w = pg8::cvt_pk_bf16(w[6], w[7]);
    w1.x = pg8::cvt_pk_bf16(w[8], w[9]); w1.y = pg8::cvt_pk_bf16(w[10], w[11]); w1.z = pg8::cvt_pk_bf16(w[12], w[13]); w1.w = pg8::cvt_pk_bf16(w[14], w[15]);
}
__device__ __forceinline__ bf16x8_t sb_vfrag(const LAS unsigned char* Vl, int rowbase, int s, int c, int lane) {
    const int hi = lane >> 5, blk = (lane >> 4) & 1, i16 = lane & 15;
    const LAS unsigned char* p = Vl + (rowbase + 16 * s + 4 * hi + (i16 >> 2)) * SB_PITCH + (32 * c + 16 * blk + 4 * (i16 & 3)) * 2;
    const v4i16_t lo = __builtin_amdgcn_ds_read_tr16_b64_v4i16((LAS v4i16_t*)p);
    const v4i16_t hh = __builtin_amdgcn_ds_read_tr16_b64_v4i16((LAS v4i16_t*)(p + 8 * SB_PITCH));
    return (bf16x8_t){lo[0], lo[1], lo[2], lo[3], hh[0], hh[1], hh[2], hh[3]};
}
template <bool MASK>
__device__ __forceinline__ bool sb_tile(const LAS unsigned char* Kl, const LAS unsigned char* Vl, int trow, int key0, int row, bool do_p1, const bf16x8_t (&qf)[4], f32x16& o0, f32x16& o1, float& carry, int lane) {
    const int r32 = lane & 31, hi = lane >> 5;
    f32x16 zero;
#pragma unroll
    for (int i = 0; i < 16; ++i) zero[i] = 0.f;
    if (do_p1) {
        f32x16 p = zero;
#pragma unroll
        for (int ks = 0; ks < 4; ++ks) { const bf16x8_t a = *(const LAS bf16x8_t*)(Kl + (trow + 32 + r32) * SB_PITCH + (16 * ks + 8 * hi) * 2); p = MFMA32(a, qf[ks], p); }
        v4u w0, w1; sb_block<MASK>(p, key0 + 32, row, hi, carry, w0, w1);
        const bf16x8_t a0 = __builtin_bit_cast(bf16x8_t, w0), a1 = __builtin_bit_cast(bf16x8_t, w1);
        o0 = MFMA32(a0, sb_vfrag(Vl, trow + 32, 0, 0, lane), o0); o1 = MFMA32(a0, sb_vfrag(Vl, trow + 32, 0, 1, lane), o1);
        o0 = MFMA32(a1, sb_vfrag(Vl, trow + 32, 1, 0, lane), o0); o1 = MFMA32(a1, sb_vfrag(Vl, trow + 32, 1, 1, lane), o1);
        if (__all(carry < SB_THR)) return true;
    }
    {
        f32x16 p = zero;
#pragma unroll
        for (int ks = 0; ks < 4; ++ks) { const bf16x8_t a = *(const LAS bf16x8_t*)(Kl + (trow + r32) * SB_PITCH + (16 * ks + 8 * hi) * 2); p = MFMA32(a, qf[ks], p); }
        v4u w0, w1; sb_block<MASK>(p, key0, row, hi, carry, w0, w1);
        const bf16x8_t a0 = __builtin_bit_cast(bf16x8_t, w0), a1 = __builtin_bit_cast(bf16x8_t, w1);
        o0 = MFMA32(a0, sb_vfrag(Vl, trow, 0, 0, lane), o0); o1 = MFMA32(a0, sb_vfrag(Vl, trow, 0, 1, lane), o1);
        o0 = MFMA32(a1, sb_vfrag(Vl, trow, 1, 0, lane), o0); o1 = MFMA32(a1, sb_vfrag(Vl, trow, 1, 1, lane), o1);
    }
    return __all(carry < SB_THR);
}
__device__ __forceinline__ void sb_unit_mfma(LAS unsigned char* lds, int b, int h, int qb, const bf16* QC, const bf16* KC, const bf16* VC, const bf16* GC, bf16* O, int tid, int wave) {
    const int lane = tid & 63, r32 = lane & 31, hi = lane >> 5;
    LAS unsigned char* Kl = lds; LAS unsigned char* Vl = lds + SB_NK * SB_PITCH;
    volatile LAS unsigned* fl = (volatile LAS unsigned*)(lds + LDSCTL_OFF);
    const int q0 = qb * 256, qw = q0 + 32 * wave, row = qw + r32;
    const size_t tokb = (size_t)b * T;
    bf16x8_t qf[4];
#pragma unroll
    for (int ks = 0; ks < 4; ++ks) qf[ks] = *(const bf16x8_t*)(QC + (tokb + row) * 256 + h * 64 + 16 * ks + 8 * hi);
    f32x16 o0, o1;
#pragma unroll
    for (int i = 0; i < 16; ++i) { o0[i] = 0.f; o1[i] = 0.f; }
    float carry = 1.0f; int done = 0;
    int hi_key = q0 + 256, lo_key = hi_key > SB_NK ? hi_key - SB_NK : 0;
    const int kmax = qw + 30, T0 = kmax >> 6;
    for (;;) {
        __syncthreads();
        const int nch = (hi_key - lo_key) * 8;
        for (int cidx = tid; cidx < nch; cidx += NTHR) { const int r = cidx >> 3, ch = cidx & 7; const size_t g = (tokb + lo_key + r) * 256 + h * 64 + 8 * ch;
            *(LAS v4u*)(Kl + r * SB_PITCH + ch * 16) = *(const v4u*)(KC + g); *(LAS v4u*)(Vl + r * SB_PITCH + ch * 16) = *(const v4u*)(VC + g); }
        __syncthreads();
        if (!done) {
            const int Ttop = min(T0, (hi_key - 1) >> 6), Tlo = lo_key >> 6;
            for (int Tt = Ttop; Tt >= Tlo; --Tt) {
                const int key0 = 64 * Tt, trow = key0 - lo_key;
                bool fin;
                if (key0 + 63 >= qw) fin = sb_tile<true>(Kl, Vl, trow, key0, row, key0 + 32 <= kmax, qf, o0, o1, carry, lane);
                else fin = sb_tile<false>(Kl, Vl, trow, key0, row, true, qf, o0, o1, carry, lane);
                if (fin) { done = 1; break; }
            }
        }
        if (lane == 0) fl[wave] = (unsigned)done;
        __syncthreads();
        const unsigned all = fl[0] & fl[1] & fl[2] & fl[3] & fl[4] & fl[5] & fl[6] & fl[7];
        if (all || lo_key == 0) break;
        hi_key = lo_key; lo_key = hi_key > SB_NK ? hi_key - SB_NK : 0;
    }
    {
        LAS float* stg = (LAS float*)(lds + wave * 8704);
#pragma unroll
        for (int i = 0; i < 16; ++i) { stg[crow16(i, hi) * 68 + r32] = o0[i]; stg[crow16(i, hi) * 68 + 32 + r32] = o1[i]; }
        asm volatile("s_waitcnt lgkmcnt(0)" ::: "memory");
        const int rw = lane >> 1, hf = lane & 1; const size_t rr = tokb + qw + rw;
        const bf16* gp = GC + rr * 256 + h * 64 + 32 * hf; bf16* op = O + rr * D + 768 + h * 64 + 32 * hf; const LAS float* sp = stg + rw * 68 + 32 * hf;
#pragma unroll
        for (int q8 = 0; q8 < 4; ++q8) {
            const v4u gg = *(const v4u*)(gp + 8 * q8); const f32x4 a = *(const LAS f32x4*)(sp + 8 * q8), b2 = *(const LAS f32x4*)(sp + 8 * q8 + 4);
            v4u w; w.x = pg8::cvt_pk_bf16(a[0] * bflo(gg.x), a[1] * bfhi(gg.x)); w.y = pg8::cvt_pk_bf16(a[2] * bflo(gg.y), a[3] * bfhi(gg.y));
            w.z = pg8::cvt_pk_bf16(b2[0] * bflo(gg.z), b2[1] * bfhi(gg.z)); w.w = pg8::cvt_pk_bf16(b2[2] * bflo(gg.w), b2[3] * bfhi(gg.w));
            *(v4u*)(op + 8 * q8) = w;
        }
    }
}

#define SB_BARRIER() do { asm volatile("s_waitcnt lgkmcnt(0)" ::: "memory"); __builtin_amdgcn_s_barrier(); asm volatile("" ::: "memory"); } while (0)
__device__ __forceinline__ void sb_units_pipe(LAS unsigned char* lds, int n_units, int u0, int ustride, int uskip, const bf16* QC, const bf16* KC, const bf16* VC, const bf16* GC, bf16* O, int tid, int wave) {
    int tl = tid; asm volatile("" : "+v"(tl));
    int lane = tl & 63, r32 = lane & 31, hi = lane >> 5;
    LAS unsigned char* Kl = lds; LAS unsigned char* Vl = lds + SB_NK * SB_PITCH;
    volatile LAS unsigned* fl = (volatile LAS unsigned*)(lds + LDSCTL_OFF);
    constexpr int NPRE = (SB_NK * 8 + NTHR - 1) / NTHR;
    v4u kpre[NPRE], vpre[NPRE]; bf16x8_t qpre[4];
#define SB_PREFETCH(u_) do { const int bh_ = (u_) & 127, qb_ = 7 - ((u_) >> 7), h_ = bh_ & 3; const size_t tb_ = (size_t)(bh_ >> 2) * T; \
        const int hk_ = qb_ * 256 + 256, lk_ = hk_ > SB_NK ? hk_ - SB_NK : 0, nch_ = (hk_ - lk_) * 8; \
        _Pragma("unroll") for (int j = 0; j < NPRE; ++j) { const int ci_ = tl + NTHR * j; if (ci_ < nch_) { const size_t g_ = (tb_ + lk_ + (ci_ >> 3)) * 256 + h_ * 64 + 8 * (ci_ & 7); kpre[j] = *(const v4u*)(KC + g_); vpre[j] = *(const v4u*)(VC + g_); } } \
        _Pragma("unroll") for (int ks = 0; ks < 4; ++ks) qpre[ks] = *(const bf16x8_t*)(QC + (tb_ + qb_ * 256 + 32 * wave + r32) * 256 + h_ * 64 + 16 * ks + 8 * hi); } while (0)
    if (n_units > 0) SB_PREFETCH(u0);
    for (int iu = 0; iu < n_units; ++iu) {
        tl = tid; asm volatile("" : "+v"(tl)); lane = tl & 63; r32 = lane & 31; hi = lane >> 5;
        const int u = u0 + ustride * iu + (iu ? uskip : 0), bh = u & 127, qb = 7 - (u >> 7), b = bh >> 2, h = bh & 3;
        const int q0 = qb * 256, qw = q0 + 32 * wave, row = qw + r32;
        const size_t tokb = (size_t)b * T;
        int hi_key = q0 + 256, lo_key = hi_key > SB_NK ? hi_key - SB_NK : 0;
        SB_BARRIER();
        { const int nch = (hi_key - lo_key) * 8;
#pragma unroll
          for (int j = 0; j < NPRE; ++j) { const int ci = tl + NTHR * j; if (ci < nch) { *(LAS v4u*)(Kl + (ci >> 3) * SB_PITCH + (ci & 7) * 16) = kpre[j]; *(LAS v4u*)(Vl + (ci >> 3) * SB_PITCH + (ci & 7) * 16) = vpre[j]; } } }
        bf16x8_t qf[4]; v4u gate[4];
#pragma unroll
        for (int ks = 0; ks < 4; ++ks) { qf[ks] = qpre[ks]; gate[ks] = *(const v4u*)(GC + (tokb + qw + (lane >> 1)) * 256 + h * 64 + 32 * (lane & 1) + 8 * ks); }
        SB_BARRIER();
        if (iu + 1 < n_units) SB_PREFETCH(u0 + ustride * (iu + 1) + uskip);
        f32x16 o0, o1;
#pragma unroll
        for (int i = 0; i < 16; ++i) { o0[i] = 0.f; o1[i] = 0.f; }
        float carry = 1.0f; int done = 0;
        const int kmax = qw + 30, T0 = kmax >> 6;
        for (bool first = true;; first = false) {
            if (!first) {
                SB_BARRIER();
                const int nch = (hi_key - lo_key) * 8;
                for (int cidx = tl; cidx < nch; cidx += NTHR) { const int r = cidx >> 3, ch = cidx & 7; const size_t g = (tokb + lo_key + r) * 256 + h * 64 + 8 * ch;
                    *(LAS v4u*)(Kl + r * SB_PITCH + ch * 16) = *(const v4u*)(KC + g); *(LAS v4u*)(Vl + r * SB_PITCH + ch * 16) = *(const v4u*)(VC + g); }
                SB_BARRIER();
            }
            if (!done) {
                const int Ttop = min(T0, (hi_key - 1) >> 6), Tlo = lo_key >> 6;
                for (int Tt = Ttop; Tt >= Tlo; --Tt) {
                    const int key0 = 64 * Tt, trow = key0 - lo_key;
                    bool fin;
                    if (key0 + 63 >= qw) fin = sb_tile<true>(Kl, Vl, trow, key0, row, key0 + 32 <= kmax, qf, o0, o1, carry, lane);
                    else fin = sb_tile<false>(Kl, Vl, trow, key0, row, true, qf, o0, o1, carry, lane);
                    if (fin) { done = 1; break; }
                }
            }
            if (lane == 0) fl[wave] = (unsigned)done;
            SB_BARRIER();
            const unsigned all = fl[0] & fl[1] & fl[2] & fl[3] & fl[4] & fl[5] & fl[6] & fl[7];
            if (all || lo_key == 0) break;
            hi_key = lo_key; lo_key = hi_key > SB_NK ? hi_key - SB_NK : 0;
        }
        {
            LAS float* stg = (LAS float*)(lds + wave * 8704);
#pragma unroll
            for (int i = 0; i < 16; ++i) { stg[crow16(i, hi) * 68 + r32] = o0[i]; stg[crow16(i, hi) * 68 + 32 + r32] = o1[i]; }
            asm volatile("s_waitcnt lgkmcnt(0)" ::: "memory");
            const int rw = lane >> 1, hf = lane & 1; const size_t rr = tokb + qw + rw;
            bf16* op = O + rr * D + 768 + h * 64 + 32 * hf; const LAS float* sp = stg + rw * 68 + 32 * hf;
#pragma unroll
            for (int q8 = 0; q8 < 4; ++q8) {
                const v4u gg = gate[q8]; const f32x4 a = *(const LAS f32x4*)(sp + 8 * q8), b2 = *(const LAS f32x4*)(sp + 8 * q8 + 4);
                v4u w; w.x = pg8::cvt_pk_bf16(a[0] * bflo(gg.x), a[1] * bfhi(gg.x)); w.y = pg8::cvt_pk_bf16(a[2] * bflo(gg.y), a[3] * bfhi(gg.y));
                w.z = pg8::cvt_pk_bf16(b2[0] * bflo(gg.z), b2[1] * bfhi(gg.z)); w.w = pg8::cvt_pk_bf16(b2[2] * bflo(gg.w), b2[3] * bfhi(gg.w));
                *(v4u*)(op + 8 * q8) = w;
            }
        }
    }
#undef SB_PREFETCH
}
constexpr int SC_P = 144;
template <int DV> struct ScanLds {
    static constexpr int VP = DV * 2 + 16, OP = DV + 4;
    static constexpr int QM = 0, KM = QM + 64 * SC_P, Q0 = KM + 64 * SC_P, KET = Q0 + 64 * SC_P, V = KET + 64 * SC_P, DEC = V + 64 * VP, GS = DEC + 256, OB = GS + 2048, END = OB + 64 * OP * 4;
};
__device__ __forceinline__ bf16x8_t tr_frag(const LAS unsigned char* base, int pitch, int row0, int col0, int lane) {
    const int blk = (lane >> 4) & 1, i16 = lane & 15;
    const LAS unsigned char* p = base + (row0 + (i16 >> 2)) * pitch + (col0 + 16 * blk + 4 * (i16 & 3)) * 2;
    const v4i16_t lo = __builtin_amdgcn_ds_read_tr16_b64_v4i16((LAS v4i16_t*)p);
    return (bf16x8_t){lo[0], lo[1], lo[2], lo[3], 0, 0, 0, 0};
}
__device__ __forceinline__ bf16x8_t tr_frag2(const LAS unsigned char* base, int pitch, int rowa, int rowb, int col0, int lane) {
    const int blk = (lane >> 4) & 1, i16 = lane & 15;
    const int co = (col0 + 16 * blk + 4 * (i16 & 3)) * 2;
    const v4i16_t lo = __builtin_amdgcn_ds_read_tr16_b64_v4i16((LAS v4i16_t*)(base + (rowa + (i16 >> 2)) * pitch + co));
    const v4i16_t hh = __builtin_amdgcn_ds_read_tr16_b64_v4i16((LAS v4i16_t*)(base + (rowb + (i16 >> 2)) * pitch + co));
    return (bf16x8_t){lo[0], lo[1], lo[2], lo[3], hh[0], hh[1], hh[2], hh[3]};
}
__device__ __forceinline__ bf16x8_t pack8(const f32x16& x, int s) {
    v4u w; w.x = pg8::cvt_pk_bf16(x[8 * s], x[8 * s + 1]); w.y = pg8::cvt_pk_bf16(x[8 * s + 2], x[8 * s + 3]); w.z = pg8::cvt_pk_bf16(x[8 * s + 4], x[8 * s + 5]); w.w = pg8::cvt_pk_bf16(x[8 * s + 6], x[8 * s + 7]);
    return __builtin_bit_cast(bf16x8_t, w);
}
#define LDS_BARRIER() do { asm volatile("s_waitcnt lgkmcnt(0)" ::: "memory"); __builtin_amdgcn_s_barrier(); asm volatile("" ::: "memory"); } while (0)
template <int DV, bool GLA>
__device__ __forceinline__ void scan_unit_mfma(LAS unsigned char* lds, int b, int h, const bf16* Qs, const bf16* Ks, const bf16* Gs, const bf16* Vs, const bf16* Gate, const bf16* LRA,
                                               const float* w2, const float* bg, const float* normw, bf16* O, int ocol0, int tid, int wave) {
    typedef ScanLds<DV> L;
    constexpr int G2OFF = L::END;
    constexpr int RQ = G2OFF + 16384, RK = RQ + 64 * SC_P, RG = RK + 64 * SC_P;
    static_assert(RG + 64 * SC_P <= RING_BYTES, "scan LDS");
    constexpr int VPT = DV / 8, CPT = DV / 8, NC = T / 64;
    const int lane = tid & 63, r32 = lane & 31, hi = lane >> 5;
    const int ti = wave >> 2, cb = wave & 3; const bool mma_on = (32 * cb < DV);
    LAS float* gsum = (LAS float*)(lds + L::GS); LAS float* dec = (LAS float*)(lds + L::DEC); LAS float* obuf = (LAS float*)(lds + L::OB); LAS float* g2 = (LAS float*)(lds + G2OFF);
    f32x16 S0, S1;
    unsigned cmask[8];
#pragma unroll
    for (int j = 0; j < 8; ++j) cmask[j] = ((crow16(2 * j, hi) <= r32) ? 0x0000FFFFu : 0u) | ((crow16(2 * j + 1, hi) <= r32) ? 0xFFFF0000u : 0u);
#pragma unroll
    for (int i = 0; i < 16; ++i) { S0[i] = 0.f; S1[i] = 0.f; }
    const int srow = tid >> 3, sseg = tid & 7;
    const size_t tokb = (size_t)b * T;
    (void)normw;
    const int gm = (wave >> 1) & 1, gn = wave & 1;
    bf16x8_t w2f = {0, 0, 0, 0, 0, 0, 0, 0}; float gbias = 0.f, gbl2_ = 0.f; v4u lraR = {0u, 0u, 0u, 0u};
    f32x16 zero16;
#pragma unroll
    for (int i = 0; i < 16; ++i) zero16[i] = 0.f;
    if (GLA && wave < 4) {
        v4u w;
        const float* wp = w2 + (8 * hi) * 256 + h * 64 + 32 * gn + r32;
        w.x = pg8::cvt_pk_bf16(wp[0], wp[256]); w.y = pg8::cvt_pk_bf16(wp[512], wp[768]); w.z = pg8::cvt_pk_bf16(wp[1024], wp[1280]); w.w = pg8::cvt_pk_bf16(wp[1536], wp[1792]);
        w2f = __builtin_bit_cast(bf16x8_t, w); gbias = bg[h * 64 + 32 * gn + r32]; gbl2_ = gbias * (-LOG2E);
    }
#define SCAN_GATE_BLOCK(chunk) do {   \
        const f32x16 zz = MFMA32(__builtin_bit_cast(bf16x8_t, lraR), w2f, zero16); \
        _Pragma("unroll") for (int i = 0; i < 16; ++i) g2[(32 * gm + crow16(i, hi)) * 64 + 32 * gn + r32] = lg2(1.0f + ex2(fminf(__builtin_fmaf(zz[i], -LOG2E, gbl2_), 126.f))) * (-1.0f / 16.0f); } while (0)
#define SCAN_LRA_LOAD(chunk) do { lraR = *(const v4u*)(LRA + (tokb + 64 * (chunk) + 32 * gm + r32) * 16 + 8 * hi); } while (0)
    v4u qw_ = {0u, 0u, 0u, 0u}, kw_ = qw_, gw_ = qw_; v4u vraw[VPT / 8], gateR[CPT / 8];
#define SCAN_RAW_LOAD(chunk) do { const size_t t0_ = tokb + 64 * (chunk); \
        { const size_t o_ = (t0_ + srow) * 256 + h * 64 + 8 * sseg; qw_ = *(const v4u*)(Qs + o_); kw_ = *(const v4u*)(Ks + o_); if (!GLA) gw_ = *(const v4u*)(Gs + o_); } \
        _Pragma("unroll") for (int q8 = 0; q8 < VPT / 8; ++q8) vraw[q8] = *(const v4u*)(Vs + (t0_ + srow) * (size_t)(4 * DV) + h * DV + VPT * sseg + 8 * q8); } while (0)
#define SCAN_RAW_TO_LDS() do { *(LAS v4u*)(lds + RQ + srow * SC_P + 16 * sseg) = qw_; *(LAS v4u*)(lds + RK + srow * SC_P + 16 * sseg) = kw_; if (!GLA) *(LAS v4u*)(lds + RG + srow * SC_P + 16 * sseg) = gw_; } while (0)
#define SCAN_GATE_LOAD(chunk) do { _Pragma("unroll") for (int q8 = 0; q8 < CPT / 8; ++q8) gateR[q8] = *(const v4u*)(Gate + (tokb + 64 * (chunk) + srow) * (size_t)(4 * DV) + h * DV + CPT * sseg + 8 * q8); } while (0)
    __syncthreads();
    if (GLA && wave < 4) { SCAN_LRA_LOAD(0); SCAN_GATE_BLOCK(0); SCAN_LRA_LOAD(1); }
    SCAN_RAW_LOAD(0); SCAN_GATE_LOAD(0); SCAN_RAW_TO_LDS();
    { const size_t o_ = (tokb + 64 + srow) * 256 + h * 64 + 8 * sseg; qw_ = *(const v4u*)(Qs + o_); kw_ = *(const v4u*)(Ks + o_); if (!GLA) gw_ = *(const v4u*)(Gs + o_); }
    __syncthreads();
    for (int c = 0; c < NC; ++c) {
        const size_t tok0 = tokb + 64 * c;
        const int cn = c + 1 < NC ? c + 1 : NC - 1, cnn = c + 2 < NC ? c + 2 : NC - 1;
        float g[8];
#pragma unroll
        for (int i = 0; i < 8; ++i) g[i] = GLA ? g2[(8 * wave + i) * 64 + lane] : bflo((unsigned)*(const LAS bf16*)(lds + RG + (8 * wave + i) * SC_P + lane * 2));
#pragma unroll
        for (int i = 1; i < 8; ++i) g[i] += g[i - 1];
        gsum[wave * 64 + lane] = g[7];
#pragma unroll
        for (int q8 = 0; q8 < VPT / 8; ++q8) *(LAS v4u*)(lds + L::V + srow * L::VP + (VPT * sseg + 8 * q8) * 2) = vraw[q8];
        LDS_BARRIER();
        float off = 0.f, bmid = 0.f, ball = 0.f;
#pragma unroll
        for (int w = 0; w < 8; ++w) { const float s = gsum[w * 64 + lane]; if (w < wave) off += s; if (w < 4) bmid += s; ball += s; }
        {
            const float ofs_ = off - bmid;
            float ke[8], q0v_[8]; const float cm_ = ex2(bmid), ca_ = ex2(ball - bmid);
#pragma unroll
            for (int i = 0; i < 8; ++i) {
                const int t = 8 * wave + i; const float qv = bflo((unsigned)*(const LAS bf16*)(lds + RQ + t * SC_P + lane * 2)), kv = bflo((unsigned)*(const LAS bf16*)(lds + RK + t * SC_P + lane * 2));
                const float xc = fminf(fmaxf(g[i] + ofs_, -100.f), 100.f); const float eq = ex2(xc), ek = ex2(-xc);
                const float qm_ = qv * eq, km_ = kv * ek;
                { const unsigned w2_ = pg8::cvt_pk_bf16(qm_, km_);
                  *(LAS unsigned short*)(lds + L::QM + t * SC_P + lane * 2) = (unsigned short)w2_;
                  *(LAS unsigned short*)(lds + L::KM + t * SC_P + lane * 2) = (unsigned short)(w2_ >> 16); }
                q0v_[i] = qm_ * cm_;
                ke[i] = km_ * ca_;
            }
#pragma unroll
            for (int i = 0; i < 8; i += 2) { const int t = 8 * wave + i; const unsigned w2_ = pg8::cvt_pk_bf16(q0v_[i], q0v_[i + 1]);
                *(LAS unsigned short*)(lds + L::Q0 + t * SC_P + lane * 2) = (unsigned short)w2_;
                *(LAS unsigned short*)(lds + L::Q0 + (t + 1) * SC_P + lane * 2) = (unsigned short)(w2_ >> 16); }
            v4u w; w.x = pg8::cvt_pk_bf16(ke[0], ke[1]); w.y = pg8::cvt_pk_bf16(ke[2], ke[3]); w.z = pg8::cvt_pk_bf16(ke[4], ke[5]); w.w = pg8::cvt_pk_bf16(ke[6], ke[7]);
            *(LAS v4u*)(lds + L::KET + lane * SC_P + 16 * wave) = w;
            if (wave == 0) dec[lane] = ex2(ball);
        }
        LDS_BARRIER();
        SCAN_RAW_TO_LDS();
        { const size_t o_ = (tokb + 64 * cnn + srow) * 256 + h * 64 + 8 * sseg; qw_ = *(const v4u*)(Qs + o_); kw_ = *(const v4u*)(Ks + o_); if (!GLA) gw_ = *(const v4u*)(Gs + o_); }
        _Pragma("unroll") for (int q8 = 0; q8 < VPT / 8; ++q8) vraw[q8] = *(const v4u*)(Vs + (tokb + 64 * cn + srow) * (size_t)(4 * DV) + h * DV + VPT * sseg + 8 * q8);
        if (GLA && wave < 4) { SCAN_GATE_BLOCK(cn); SCAN_LRA_LOAD(cnn); }
        if (mma_on) {
            f32x16 o;
#pragma unroll
            for (int i = 0; i < 16; ++i) o[i] = 0.f;
#pragma unroll
            for (int di = 0; di < 2; ++di)
#pragma unroll
                for (int s2 = 0; s2 < 2; ++s2) {
                    const LAS unsigned char* qp = lds + L::Q0 + (32 * ti + r32) * SC_P + (32 * di + 16 * s2 + 4 * hi) * 2;
                    const v2u a_lo = *(const LAS v2u*)qp, a_hi = *(const LAS v2u*)(qp + 16);
                    const v4u aw = {a_lo.x, a_lo.y, a_hi.x, a_hi.y};
                    o = MFMA32(__builtin_bit_cast(bf16x8_t, aw), pack8(di == 0 ? S0 : S1, s2), o);
                }
#pragma unroll
            for (int sj = 0; sj < 2; ++sj) {
                if (sj <= ti) {
                    f32x16 sc;
#pragma unroll
                    for (int i = 0; i < 16; ++i) sc[i] = 0.f;
#pragma unroll
                    for (int ks = 0; ks < 4; ++ks) {
                        const bf16x8_t a = *(const LAS bf16x8_t*)(lds + L::KM + (32 * sj + r32) * SC_P + (16 * ks + 8 * hi) * 2);
                        const bf16x8_t bq = *(const LAS bf16x8_t*)(lds + L::QM + (32 * ti + r32) * SC_P + (16 * ks + 8 * hi) * 2);
                        sc = MFMA32(a, bq, sc);
                    }
#pragma unroll
                    for (int s2 = 0; s2 < 2; ++s2) {
                        v4u pw_ = __builtin_bit_cast(v4u, pack8(sc, s2));
                        if (sj == ti) { pw_.x &= cmask[4 * s2]; pw_.y &= cmask[4 * s2 + 1]; pw_.z &= cmask[4 * s2 + 2]; pw_.w &= cmask[4 * s2 + 3]; }
                        o = MFMA32(__builtin_bit_cast(bf16x8_t, pw_), tr_frag2(lds + L::V, L::VP, 32 * sj + 16 * s2 + 4 * hi, 32 * sj + 16 * s2 + 8 + 4 * hi, 32 * cb, lane), o);
                    }
                }
            }
#pragma unroll
            for (int j4 = 0; j4 < 4; ++j4) {
                const f32x4 d0 = *(const LAS f32x4*)(dec + 8 * j4 + 4 * hi), d1 = *(const LAS f32x4*)(dec + 32 + 8 * j4 + 4 * hi);
#pragma unroll
                for (int e = 0; e < 4; ++e) { S0[4 * j4 + e] *= d0[e]; S1[4 * j4 + e] *= d1[e]; }
            }
#pragma unroll
            for (int ks = 0; ks < 4; ++ks) {
                const bf16x8_t vb = tr_frag2(lds + L::V, L::VP, 16 * ks + 8 * hi, 16 * ks + 8 * hi + 4, 32 * cb, lane);
                const bf16x8_t a0 = *(const LAS bf16x8_t*)(lds + L::KET + r32 * SC_P + (16 * ks + 8 * hi) * 2);
                const bf16x8_t a1 = *(const LAS bf16x8_t*)(lds + L::KET + (32 + r32) * SC_P + (16 * ks + 8 * hi) * 2);
                S0 = MFMA32(a0, vb, S0); S1 = MFMA32(a1, vb, S1);
            }
#pragma unroll
            for (int i = 0; i < 16; ++i) obuf[(32 * ti + crow16(i, hi)) * L::OP + 32 * cb + r32] = o[i];
        }
        LDS_BARRIER();
        {
            const LAS float* orow = obuf + srow * L::OP + CPT * sseg; float x[CPT]; float ss = 0.f;
#pragma unroll
            for (int j = 0; j < CPT; ++j) x[j] = orow[j];
            { float s0_ = 0.f, s1_ = 0.f;
#pragma unroll
              for (int j = 0; j < CPT; j += 2) { s0_ = __builtin_fmaf(x[j], x[j], s0_); s1_ = __builtin_fmaf(x[j + 1], x[j + 1], s1_); }
              ss = s0_ + s1_; }
            ss += __builtin_bit_cast(float, __builtin_amdgcn_update_dpp(0, __builtin_bit_cast(int, ss), 0xB1, 0xF, 0xF, true));
            ss += __builtin_bit_cast(float, __builtin_amdgcn_update_dpp(0, __builtin_bit_cast(int, ss), 0x4E, 0xF, 0xF, true));
            ss += __builtin_bit_cast(float, __builtin_amdgcn_update_dpp(0, __builtin_bit_cast(int, ss), 0x141, 0xF, 0xF, true));
            const float rstd = rsqrtf(ss * (1.0f / DV) + EPS);
            bf16* op = O + (tok0 + srow) * (size_t)D + ocol0 + h * DV + CPT * sseg;
#pragma unroll
            for (int q8 = 0; q8 < CPT / 8; ++q8) { const v4u gg = gateR[q8];
                const float gt[8] = {bflo(gg.x), bfhi(gg.x), bflo(gg.y), bfhi(gg.y), bflo(gg.z), bfhi(gg.z), bflo(gg.w), bfhi(gg.w)}; float y[8];
#pragma unroll
                for (int j = 0; j < 8; ++j) y[j] = x[8 * q8 + j] * rstd * gt[j];
                v4u w; w.x = pg8::cvt_pk_bf16(y[0], y[1]); w.y = pg8::cvt_pk_bf16(y[2], y[3]); w.z = pg8::cvt_pk_bf16(y[4], y[5]); w.w = pg8::cvt_pk_bf16(y[6], y[7]); *(v4u*)(op + 8 * q8) = w; }
            SCAN_GATE_LOAD(cn);
        }
    }
    __syncthreads();
#undef SCAN_GATE_BLOCK
#undef SCAN_LRA_LOAD
#undef SCAN_RAW_LOAD
#undef SCAN_RAW_TO_LDS
#undef SCAN_GATE_LOAD
}
struct RevOrder {
    pg8::StaticOrder S;
    __device__ __forceinline__ bool next(int i, pg8::Unit& u) const { return i < 4 && S.next(3 - i, u); }
    __device__ __forceinline__ void a_ready(const pg8::Unit&) const {}
    __device__ __forceinline__ void done(const pg8::Unit&) const {}
};
struct Args { const float* in[12]; float* out; unsigned char* ws; int ph_lo, ph_hi; };
__global__ void __launch_bounds__(NTHR, 2) fwd_kernel(Args args) {
    extern __shared__ __attribute__((aligned(16))) unsigned char lds_raw[];
    LAS unsigned char* lds = (LAS unsigned char*)lds_raw;
    volatile LAS unsigned* MISC = (volatile LAS unsigned*)(lds + MISC_OFF);
    const int tid = threadIdx.x, lane = tid & 63, wave = __builtin_amdgcn_readfirstlane(tid >> 6);
    const int G = gridDim.x, bx = blockIdx.x, vcu = (G % 8 == 0) ? (bx % 8) * (G / 8) + bx / 8 : bx;
    unsigned char* ws = args.ws;
    gu32* ctl = (gu32*)(ws + WS_CTL);
    const float* x_in = args.in[0]; const float* c_in = args.in[1]; const float* w_ada = args.in[2]; const float* b_ada = args.in[3]; const float* w_in = args.in[4];
    const float* w_g2 = args.in[5]; const float* b_g = args.in[6]; const float* gla_nw = args.in[7]; const float* lb_logits = args.in[8]; const float* hgrn_nw = args.in[9];
    const float* w_out = args.in[10]; const float* final_w = args.in[11];
    bf16* XB = (bf16*)(ws + WS_XB);
    float* ADA = (float*)(ws + WS_ADA); float* LB = (float*)(ws + WS_LB);
    bf16* WIN = (bf16*)(ws + WS_WIN); bf16* WOUT = (bf16*)(ws + WS_WOUT); bf16* HN = (bf16*)(ws + WS_HN); bf16* OB = (bf16*)(ws + WS_O);
    unsigned char* P = ws + WS_P;
    bf16* YB = (bf16*)(ws + WS_P);
    for (int u = tid; u < (LDS_BYTES - LDSCTL_OFF) / 4; u += NTHR) ((LAS unsigned*)(lds + LDSCTL_OFF))[u] = 0u;
    __syncthreads();
    XcdBarrier bar; bar.bar = (unsigned*)(ctl + CW_BAR); bar.x = 0; bar.w = (unsigned)wave; bar.st = nullptr;
    if (!MK_PER_PHASE) bar = xcd_barrier_post((unsigned*)(ctl + CW_BAR), MISC + 8);
    const int lo = args.ph_lo, hi = args.ph_hi;
#define IN(k) (lo <= (k) && (k) < hi)
#define SEAM(k) do { if (IN(k) && IN((k) + 1)) xcd_barrier(bar); } while (0)
    const int gw = vcu * NWAVES + wave, NGW = G * NWAVES;

#ifndef NO_P0
    if (IN(0)) {
        LAS float* scr = (LAS float*)(lds + wave * 16384);
        constexpr int I_IN = (D / 64) * (NIN / 32), I_OUT = (D / 64) * (D / 32), NIT = DEPTH * (I_IN + I_OUT);
#define P0_DEC(it_, W_, WT_, NS_, NB_, WM_, R_) const int l_##R_ = (it_) / (I_IN + I_OUT), R_##x = (it_) % (I_IN + I_OUT); const bool WM_ = R_##x < I_IN; \
            const float* W_ = WM_ ? w_in + (size_t)l_##R_ * D * DIN : w_out + (size_t)l_##R_ * D * D; bf16* WT_ = WM_ ? WIN + (size_t)l_##R_ * NIN * D : WOUT + (size_t)l_##R_ * D * D; \
            const int NS_ = WM_ ? DIN : D, NB_ = WM_ ? NIN / 32 : D / 32, R_ = WM_ ? R_##x : R_##x - I_IN;
        {
            f32x4 cur[8]; int it = gw;
            if (it < NIT) { P0_DEC(it, W0, T0_, NS0, NB0, WM0, r0); p0_tr_load(W0, NS0, NB0, WM0, r0, lane, cur, gla_nw + l_r0 * 128, hgrn_nw + l_r0 * 64); }
            while (it < NIT) {
                const int itn = it + NGW; f32x4 nxt[8];
                if (itn < NIT) { P0_DEC(itn, W1, T1_, NS1, NB1, WM1, r1); p0_tr_load(W1, NS1, NB1, WM1, r1, lane, nxt, gla_nw + l_r1 * 128, hgrn_nw + l_r1 * 64); }
                { P0_DEC(it, W2, T2_, NS2, NB2, WM2, r2); p0_tr_finish(cur, D, NB2, T2_, scr, r2, lane); }
#pragma unroll
                for (int i = 0; i < 8; ++i) cur[i] = nxt[i];
                it = itn;
            }
        }
#undef P0_DEC
        __syncthreads();
        for (int it = vcu; it < DEPTH * 48; it += G) p0_ada_item(c_in, w_ada, b_ada, ADA, (LAS float*)lds, it, tid, wave, lane);
        if (vcu == G - 1 && tid < 256) {
            float lg[4], mx = -INFINITY, sum = 0.f;
#pragma unroll
            for (int l = 0; l < 4; ++l) { lg[l] = lb_logits[l * 256 + tid]; mx = fmaxf(mx, lg[l]); }
#pragma unroll
            for (int l = 0; l < 4; ++l) { lg[l] = expf(lg[l] - mx); sum += lg[l]; }
            const float inv = 1.0f / sum; const float p1 = lg[1] * inv, p2 = lg[2] * inv, p3 = lg[3] * inv;
            LB[tid] = 0.f; LB[256 + tid] = p1; LB[512 + tid] = p1 + p2; LB[768 + tid] = p1 + p2 + p3;
        }
    }
#endif
    SEAM(0);
    if (IN(1)) { int t_ = wave * 64 + pg8::hw_lane(); asm volatile("" : "+v"(t_)); const int gw_ = vcu * NWAVES + __builtin_amdgcn_readfirstlane(t_ >> 6);
        row_pass<true, false, true>(x_in, XB, YB, ADA, ADA, final_w, args.out, XB, HN, gw_, NGW, t_ & 63); }
    SEAM(1);
    for (int l = 0; l < DEPTH; ++l) {
        const int pb = 1 + 3 * l;
        const float* ada_l = ADA + (size_t)l * 32 * 3072;
#ifndef NO_GA
        if (IN(pb + 1)) {
            pg8::Gemm g{HN, WIN + (size_t)l * NIN * D, M, NIN, D, wave}; pg8::StaticOrder S; S.init(M, NIN, G, bx);
            pg8::EpiIn E{P, LB + l * 256};
            pg8::gemm_phase<pg8::EpiIn, pg8::StaticOrder, true, true>(lds, g, S, E);
        }
#endif
        SEAM(pb + 1);
        if (IN(pb + 2)) {
            int tid_b = wave * 64 + pg8::hw_lane(); asm volatile("" : "+v"(tid_b)); const int wave_b = __builtin_amdgcn_readfirstlane(tid_b >> 6);
#ifndef NO_SCAN
            for (int u = vcu; u < 256; u += G) {
                const int b = (u & 127) >> 2, h = u & 3;
                if (u < 128) scan_unit_mfma<128, true>(lds, b, h, (const bf16*)(P + P_QA), (const bf16*)(P + P_KA), nullptr, (const bf16*)(P + P_VA), (const bf16*)(P + P_GA), (const bf16*)(P + P_LRA),
                                                       w_g2 + (size_t)l * 16 * 256, b_g + l * 256, gla_nw + l * 128, OB, 0, tid_b, wave_b);
                else scan_unit_mfma<64, false>(lds, b, h, (const bf16*)(P + P_QB), (const bf16*)(P + P_KB), (const bf16*)(P + P_GFB), (const bf16*)(P + P_IB), (const bf16*)(P + P_GB), nullptr,
                                               nullptr, nullptr, hgrn_nw + l * 64, OB, 512, tid_b, wave_b);
            }
#endif
#ifndef NO_SB
            const bool bal_ = (G == 256); const int sb_n = bal_ ? (vcu < 128 ? 3 : 5) : (1024 - vcu + G - 1) / G, sb_0 = bal_ ? (vcu < 128 ? vcu : 128 + (vcu - 128)) : vcu, sb_s = bal_ ? 128 : G, sb_k = (bal_ && vcu < 128) ? 640 : 0;
            sb_units_pipe(lds, sb_n, sb_0, sb_s, sb_k, (const bf16*)(P + P_QC), (const bf16*)(P + P_KC), (const bf16*)(P + P_VC), (const bf16*)(P + P_GC), OB, tid_b, wave_b);
#endif
        }
        SEAM(pb + 2);
#ifndef NO_GC
        if (IN(pb + 3)) {
            pg8::Gemm g{OB, WOUT + (size_t)l * D * D, M, D, D, wave}; RevOrder S; S.S.init(M, D, G, bx);
            float* part_l = (float*)(ws + WS_PART) + (size_t)l * M * 16; unsigned* cnt_l = (unsigned*)(ctl + CW_PANEL) + l * 256 * 16;
            if (l == 0) { pg8::EpiNorm<true, false> E{x_in, (pg8::bf16_t*)XB, ada_l + 2048, ada_l + 32 * 3072, (pg8::bf16_t*)HN, args.out, part_l, cnt_l}; pg8::gemm_phase<pg8::EpiNorm<true, false>, RevOrder, true, true>(lds, g, S, E); }
            else if (l < DEPTH - 1) { pg8::EpiNorm<false, false> E{x_in, (pg8::bf16_t*)XB, ada_l + 2048, ada_l + 32 * 3072, (pg8::bf16_t*)HN, args.out, part_l, cnt_l}; pg8::gemm_phase<pg8::EpiNorm<false, false>, RevOrder, true, true>(lds, g, S, E); }
            else { pg8::EpiNorm<false, true> E{x_in, (pg8::bf16_t*)XB, ada_l + 2048, final_w, (pg8::bf16_t*)HN, args.out, part_l, cnt_l}; pg8::gemm_phase<pg8::EpiNorm<false, true>, RevOrder, true, true>(lds, g, S, E); }
        }
#endif
        SEAM(pb + 3);
    }
#undef IN
#undef SEAM
}

extern "C" void kernel_launch(void* const* d_in, const int* in_sizes, int n_in, void* d_out, int out_size, void* d_ws, size_t ws_size, hipStream_t stream) {
    static int grid = 0;
    if (grid == 0) {
        if (n_in != 12 || in_sizes[0] != M * D || out_size != M * D || ws_size < WS_END) { fprintf(stderr, "kernel_launch: unexpected shapes / workspace (n_in %d, ws %zu < %zu)\n", n_in, ws_size, (size_t)WS_END); grid = -1; return; }
        int dev = 0, cus = 0, per_cu = 0;
        if (hipGetDevice(&dev) != hipSuccess || hipDeviceGetAttribute(&cus, hipDeviceAttributeMultiprocessorCount, dev) != hipSuccess) { grid = -1; return; }
        if (hipFuncSetAttribute((const void*)fwd_kernel, hipFuncAttributeMaxDynamicSharedMemorySize, LDS_BYTES) != hipSuccess) { fprintf(stderr, "kernel_launch: hipFuncSetAttribute failed\n"); grid = -1; return; }
        if (hipOccupancyMaxActiveBlocksPerMultiprocessor(&per_cu, (const void*)fwd_kernel, NTHR, LDS_BYTES) != hipSuccess || per_cu < 1) fprintf(stderr, "kernel_launch: occupancy query reports %d\n", per_cu);
        (void)hipGetLastError();
        grid = cus;
    }
    if (grid < 0) return;
    if (hipMemsetAsync((char*)d_ws + WS_CTL, 0, CTL_ZERO_BYTES, stream) != hipSuccess) return;
    Args a{};
    for (int i = 0; i < 12; ++i) a.in[i] = (const float*)d_in[i];
    a.out = (float*)d_out; a.ws = (unsigned char*)d_ws;
#if MK_PER_PHASE
    for (int p = 0; p < N_PHASES; ++p) { a.ph_lo = p; a.ph_hi = p + 1; hipLaunchKernelGGL(fwd_kernel, dim3(grid), dim3(NTHR), LDS_BYTES, stream, a); }
#else
    a.ph_lo = 0; a.ph_hi = N_PHASES; hipLaunchKernelGGL(fwd_kernel, dim3(grid), dim3(NTHR), LDS_BYTES, stream, a);
#endif
}
```

```cpp
#include <hip/hip_runtime.h>
#include <cstdio>
#include <cstdint>
namespace pg8 {
#define PG8_LAS __attribute__((address_space(3)))
typedef unsigned short bf16_t;
typedef short bf16x8 __attribute__((ext_vector_type(8)));
typedef float f32x4 __attribute__((ext_vector_type(4)));
typedef unsigned u32x4 __attribute__((ext_vector_type(4)));
constexpr int BM = 256, BK = 64, HALF = 128, HTB = HALF * BK * 2  , STAGE_BYTES = 8 * HTB, NXCD = 8, WGM = 8;

__host__ __device__ __forceinline__ int lds_byte(int r, int c) { const int st = (r >> 4) * 2 + (c >> 5), rr = r & 15, cc = c & 31, ob = rr * 64 + cc * 2; return st * 1024 + (ob ^ (((ob >> 9) & 1) << 5)); }
__host__ __device__ __forceinline__ void stage_rc(int b, int& R, int& C) { const int st = b / 1024, sb = b % 1024, swz = sb ^ (((sb >> 9) & 1) << 5); R = (st >> 1) * 16 + swz / 64; C = (st & 1) * 32 + (swz % 64) / 2; }
__host__ __device__ __forceinline__ int perm32(int rho) { const int n = rho >> 4, i = rho & 15; return 8 * (i >> 2) + 4 * n + (i & 3); }

struct Unit { int pm, pn; };
struct Gemm { const bf16_t* A; const bf16_t* Bt; int M, N, K, wv; };
__device__ __forceinline__ int hw_lane() { unsigned m = ~0u; asm volatile("" : "+s"(m)); return (int)__builtin_amdgcn_mbcnt_hi(m, __builtin_amdgcn_mbcnt_lo(m, 0u)); }

struct StaticOrder {
    int nM, nN, nwg, G, c;
    __host__ __device__ void init(int M, int N, int G_, int c_) { nM = M / BM; nN = N / BM; nwg = nM * nN; G = G_; c = c_; }
    __host__ __device__ bool next(int i, Unit& u) const {
        const long L = (long)i * G + c; if (L >= nwg) return false;
        int wgid = (int)L; { const int q = nwg / NXCD, r = nwg % NXCD, xcd = wgid % NXCD, off = wgid / NXCD; wgid = (xcd < r ? xcd * (q + 1) : r * (q + 1) + (xcd - r) * q) + off; }
        const int nig = WGM * nN, gid = wgid / nig, fm = gid * WGM, gsz = (nM - fm) < WGM ? (nM - fm) : WGM;
        u.pm = fm + ((wgid % nig) % gsz); u.pn = (wgid % nig) / gsz; return true;
    }
    __device__ __forceinline__ void a_ready(const Unit&) const {}
    __device__ __forceinline__ void done(const Unit&) const {}
};

typedef float f32x2_t __attribute__((ext_vector_type(2))); typedef __bf16 bf16x2_t __attribute__((ext_vector_type(2)));
__device__ __forceinline__ unsigned cvt_pk_bf16(float lo, float hi) { f32x2_t v = {lo, hi}; bf16x2_t b = __builtin_convertvector(v, bf16x2_t); return __builtin_bit_cast(unsigned, b); }
template <class Epi, class Sched, bool ALIGN_EPI = false, bool SP2 = false>
__device__ __forceinline__ void gemm_phase(PG8_LAS unsigned char* lds, const Gemm g, const Sched& S, const Epi& E) {
    int tid_ = g.wv * 64 + hw_lane(); asm volatile("" : "+v"(tid_));
    const int tid = tid_, wid = __builtin_amdgcn_readfirstlane(tid >> 6), lane = tid & 63, wr = wid >> 2, wc = wid & 3, fr = lane & 15, fq = lane >> 4;
    const int K = g.K, nt = K / BK;
    unsigned voffA[2], voffB[2];
#pragma unroll
    for (int i = 0; i < 2; ++i) { int R, C; stage_rc(tid * 16 + i * 8192, R, C); const int Rb = Epi::PERM ? ((R & ~31) + perm32(R & 31)) : R;
        voffA[i] = (unsigned)(R * K + C) * 2u; voffB[i] = (unsigned)(Rb * K + C) * 2u; }
    const size_t kstep = (size_t)(BK * 2);
    const size_t hstep = (size_t)HALF * K * 2;
    const size_t tstep = 2 * hstep;
    const unsigned ldsw = (unsigned)wid * 1024u;
    const int aoff = lds_byte(wr * 64 + fr, fq * 8), boff = lds_byte(wc * 32 + fr, fq * 8);
#define PG8_SA(b, h) (((b) * 2 + (h)) * HTB)
#define PG8_SB(b, h) ((4 + (b) * 2 + (h)) * HTB)
#define PG8_STAGE(bufoff, gbase, voff) do { _Pragma("unroll") for (int _i = 0; _i < 2; ++_i) \
        __builtin_amdgcn_global_load_lds((const unsigned*)((const char*)(gbase) + (voff)[_i]), (PG8_LAS unsigned*)(lds + (bufoff) + ldsw + _i * 8192), 16, 0, 0); } while (0)
#define PG8_LDA(dst, b, h) do { _Pragma("unroll") for (int m = 0; m < 4; ++m) _Pragma("unroll") for (int k = 0; k < 2; ++k) dst[m][k] = *(const PG8_LAS bf16x8*)(lds + PG8_SA(b, h) + aoff + m * 2048 + k * 1024); } while (0)
#define PG8_LDB(dst, b, h) do { _Pragma("unroll") for (int n = 0; n < 2; ++n) _Pragma("unroll") for (int k = 0; k < 2; ++k) dst[n][k] = *(const PG8_LAS bf16x8*)(lds + PG8_SB(b, h) + boff + n * 2048 + k * 1024); } while (0)
#define PG8_MMA(ai, bj, At, Bt) do { __builtin_amdgcn_s_setprio(1); _Pragma("unroll") for (int m = 0; m < 4; ++m) _Pragma("unroll") for (int n = 0; n < 2; ++n) _Pragma("unroll") for (int k = 0; k < 2; ++k) \
        acc[ai][bj][m][n] = __builtin_amdgcn_mfma_f32_16x16x32_bf16(Bt[n][k], At[m][k], acc[ai][bj][m][n], 0, 0, 0); __builtin_amdgcn_s_setprio(0); } while (0)
#define PG8_WAIT_V(n) asm volatile("s_waitcnt vmcnt(" #n ")" ::: "memory")
#define PG8_WAIT_L(n) asm volatile("s_waitcnt lgkmcnt(" #n ")" ::: "memory")
#define PG8_BAR __builtin_amdgcn_s_barrier()
#define PG8_SCHED __builtin_amdgcn_sched_barrier(0)
    Unit cur, nxt; int ui = 0;
    if (!S.next(0, cur)) return;
    f32x4 acc[2][2][4][2];
#pragma unroll
    for (int a = 0; a < 2; ++a)
#pragma unroll
        for (int b = 0; b < 2; ++b)
#pragma unroll
            for (int m = 0; m < 4; ++m)
#pragma unroll
                for (int n = 0; n < 2; ++n) acc[a][b][m][n] = (f32x4){0.f, 0.f, 0.f, 0.f};
    bf16x8 At[4][2], B0[2][2], B1[2][2];
    const char* cA = (const char*)g.A + (size_t)cur.pm * tstep; const char* cB = (const char*)g.Bt + (size_t)cur.pn * tstep;
    S.a_ready(cur);
    if constexpr (SP2) {
        PG8_STAGE(PG8_SB(0, 0), cB, voffB); PG8_STAGE(PG8_SB(0, 1), cB + hstep, voffB); PG8_STAGE(PG8_SA(0, 0), cA, voffA); PG8_STAGE(PG8_SA(0, 1), cA + hstep, voffA);
        if (wr == 1) PG8_BAR;
        PG8_WAIT_V(2); PG8_BAR;
        PG8_STAGE(PG8_SB(1, 0), cB + kstep, voffB); PG8_STAGE(PG8_SA(1, 0), cA + kstep, voffA); PG8_STAGE(PG8_SB(1, 1), cB + hstep + kstep, voffB);
        PG8_WAIT_V(6); PG8_BAR;
    } else {
        PG8_STAGE(PG8_SB(0, 0), cB, voffB); PG8_STAGE(PG8_SA(0, 0), cA, voffA); PG8_STAGE(PG8_SB(0, 1), cB + hstep, voffB); PG8_STAGE(PG8_SA(0, 1), cA + hstep, voffA);
        if (wr == 1) PG8_BAR;
        PG8_WAIT_V(4); PG8_BAR;
        PG8_STAGE(PG8_SB(1, 0), cB + kstep, voffB); PG8_STAGE(PG8_SA(1, 0), cA + kstep, voffA); PG8_STAGE(PG8_SB(1, 1), cB + hstep + kstep, voffB);
        PG8_WAIT_V(6); PG8_BAR;
    }
    for (;;) {
        const bool has_next = S.next(ui + 1, nxt);
        const char* nA = has_next ? (const char*)g.A + (size_t)nxt.pm * tstep : cA; const char* nB = has_next ? (const char*)g.Bt + (size_t)nxt.pn * tstep : cB;
        for (int t = 0; t < nt; t += 2) {
            const bool last = (t == nt - 2);
            const char* a1 = cA + (size_t)(t + 1) * kstep;
            const char* a2 = last ? nA : cA + (size_t)(t + 2) * kstep; const char* b2 = last ? nB : cB + (size_t)(t + 2) * kstep;
            const char* a3 = a2 + kstep; const char* b3 = b2 + kstep;
            if (last && has_next) S.a_ready(nxt);
            if constexpr (SP2) {
            PG8_LDB(B0, 0, 0); PG8_LDB(B1, 0, 1); PG8_SCHED; PG8_LDA(At, 0, 0); PG8_STAGE(PG8_SA(1, 1), a1 + hstep, voffA);
            PG8_WAIT_V(8); PG8_WAIT_L(0); PG8_BAR; PG8_MMA(0, 0, At, B0); PG8_MMA(0, 1, At, B1); PG8_BAR; PG8_SCHED;
            PG8_LDA(At, 0, 1); PG8_STAGE(PG8_SB(0, 0), b2, voffB); PG8_STAGE(PG8_SB(0, 1), b2 + hstep, voffB); PG8_STAGE(PG8_SA(0, 0), a2, voffA);
            PG8_WAIT_V(8); PG8_WAIT_L(0); PG8_BAR; PG8_MMA(1, 0, At, B0); PG8_MMA(1, 1, At, B1); PG8_BAR; PG8_SCHED;
            PG8_LDB(B0, 1, 0); PG8_LDB(B1, 1, 1); PG8_SCHED; PG8_LDA(At, 1, 0); PG8_STAGE(PG8_SA(0, 1), a2 + hstep, voffA);
            PG8_WAIT_V(8); PG8_WAIT_L(0); PG8_BAR; PG8_MMA(0, 0, At, B0); PG8_MMA(0, 1, At, B1); PG8_BAR; PG8_SCHED;
            PG8_LDA(At, 1, 1); PG8_STAGE(PG8_SB(1, 0), b3, voffB); PG8_STAGE(PG8_SB(1, 1), b3 + hstep, voffB); PG8_STAGE(PG8_SA(1, 0), a3, voffA);
            PG8_WAIT_V(8); PG8_WAIT_L(0); PG8_BAR; PG8_MMA(1, 0, At, B0); PG8_MMA(1, 1, At, B1); PG8_BAR; PG8_SCHED;
            } else {
            PG8_LDB(B0, 0, 0); PG8_SCHED; PG8_LDA(At, 0, 0); PG8_STAGE(PG8_SA(1, 1), a1 + hstep, voffA);
            PG8_WAIT_L(8); PG8_BAR; PG8_WAIT_L(0); PG8_MMA(0, 0, At, B0); PG8_BAR; PG8_SCHED;
            PG8_LDB(B1, 0, 1); PG8_STAGE(PG8_SB(0, 0), b2, voffB);
            PG8_BAR; PG8_WAIT_L(0); PG8_MMA(0, 1, At, B1); PG8_BAR;
            PG8_LDA(At, 0, 1); PG8_STAGE(PG8_SA(0, 0), a2, voffA);
            PG8_BAR; PG8_WAIT_L(0); PG8_MMA(1, 0, At, B0); PG8_BAR; PG8_SCHED;
            PG8_STAGE(PG8_SB(0, 1), b2 + hstep, voffB);
            PG8_WAIT_V(6); PG8_BAR; PG8_MMA(1, 1, At, B1); PG8_BAR;
            PG8_LDB(B0, 1, 0); PG8_SCHED; PG8_LDA(At, 1, 0); PG8_STAGE(PG8_SA(0, 1), a2 + hstep, voffA);
            PG8_WAIT_L(8); PG8_BAR; PG8_WAIT_L(0); PG8_MMA(0, 0, At, B0); PG8_BAR; PG8_SCHED;
            PG8_LDB(B1, 1, 1); PG8_STAGE(PG8_SB(1, 0), b3, voffB);
            PG8_BAR; PG8_WAIT_L(0); PG8_MMA(0, 1, At, B1); PG8_BAR;
            PG8_LDA(At, 1, 1); PG8_STAGE(PG8_SA(1, 0), a3, voffA);
            PG8_BAR; PG8_WAIT_L(0); PG8_MMA(1, 0, At, B0); PG8_BAR; PG8_SCHED;
            PG8_STAGE(PG8_SB(1, 1), b3 + hstep, voffB);
            PG8_WAIT_V(6); PG8_BAR; PG8_MMA(1, 1, At, B1); PG8_BAR;
            }
        }
        if constexpr (ALIGN_EPI) { if (wr == 0) PG8_BAR; }
        if constexpr (!Epi::AFTER_DRAIN) { E(acc, cur, wr, wc, fr, fq); S.done(cur); }
        if (!has_next) break;
#pragma unroll
        for (int a = 0; a < 2; ++a)
#pragma unroll
            for (int b = 0; b < 2; ++b)
#pragma unroll
                for (int m = 0; m < 4; ++m)
#pragma unroll
                    for (int n = 0; n < 2; ++n) acc[a][b][m][n] = (f32x4){0.f, 0.f, 0.f, 0.f};
        cur = nxt; cA = nA; cB = nB; ++ui;
        if constexpr (ALIGN_EPI) { if (wr == 1) PG8_BAR; }
    }
    PG8_WAIT_V(0);
    if constexpr (!ALIGN_EPI) { if (wr == 0) PG8_BAR; }
    PG8_BAR;
    if constexpr (Epi::AFTER_DRAIN) { E.fused(acc, cur, wr, wc, fr, fq, lds, wid, lane); S.done(cur); }
#undef PG8_SA
#undef PG8_SB
#undef PG8_STAGE
#undef PG8_LDA
#undef PG8_LDB
#undef PG8_MMA
#undef PG8_WAIT_V
#undef PG8_WAIT_L
#undef PG8_BAR
#undef PG8_SCHED
}
}
constexpr int NWAVES = 8, NTHR = 512;
constexpr int BATCH = 32, T = 2048, D = 1024, DEPTH = 4, M = BATCH * T;
constexpr int DIN = 3600, NIN = 3840;
constexpr float EPS = 1e-6f, LOG2E = 1.4426950408889634f;
#ifndef MK_PER_PHASE
#define MK_PER_PHASE 0
#endif
constexpr int N_PHASES = 2 + 3 * DEPTH;

constexpr size_t MiB = 1u << 20;
constexpr size_t WS_CTL = 0, CTL_ZERO_BYTES = 1 * MiB;
constexpr size_t WS_ADA = 2 * MiB;
constexpr size_t WS_LB = 3 * MiB + 512 * 1024;
constexpr size_t WS_WIN = 4 * MiB;
constexpr size_t WS_WOUT = 34 * MiB;
constexpr size_t WS_HN = 64 * MiB;
constexpr size_t WS_O = 192 * MiB;
constexpr size_t WS_P = 320 * MiB;
constexpr size_t P_QA = 0, P_KA = 32 * MiB, P_VA = 64 * MiB, P_GA = 128 * MiB, P_QB = 192 * MiB, P_GFB = 224 * MiB, P_KB = 256 * MiB, P_IB = 288 * MiB,
                 P_GB = 320 * MiB, P_QC = 352 * MiB, P_KC = 384 * MiB, P_VC = 416 * MiB, P_GC = 448 * MiB, P_LRA = 480 * MiB;
constexpr size_t WS_XB = WS_P + 482 * MiB;
constexpr size_t WS_PART = WS_XB + 128 * MiB;
constexpr size_t WS_END = WS_PART + 16 * MiB;
constexpr int CW_PANEL = 16384;
constexpr int CW_TMO = 0, CW_CODE = 1, CW_BAR = 4096;

constexpr int RING_BYTES = 139264, LDSCTL_OFF = RING_BYTES, MISC_OFF = LDSCTL_OFF + 320, LDS_BYTES = 147456;

#define GAS __attribute__((address_space(1)))
#define LAS __attribute__((address_space(3)))
typedef unsigned short bf16;
typedef unsigned v4u __attribute__((ext_vector_type(4)));
typedef unsigned v2u __attribute__((ext_vector_type(2)));
typedef float f32x4 __attribute__((ext_vector_type(4)));
typedef GAS unsigned gu32;
#define RLX_AGENT __ATOMIC_RELAXED, __HIP_MEMORY_SCOPE_AGENT
#define LDS_WAIT() asm volatile("s_waitcnt lgkmcnt(0)" ::: "memory")
__device__ __forceinline__ unsigned f2bf(float f) { unsigned u = __builtin_bit_cast(unsigned, f); return (u + 0x7fffu + ((u >> 16) & 1u)) >> 16; }
__device__ __forceinline__ unsigned pk2(float lo, float hi) { return f2bf(lo) | (f2bf(hi) << 16); }
__device__ __forceinline__ float bflo(unsigned w) { return __uint_as_float(w << 16); }
__device__ __forceinline__ float bfhi(unsigned w) { return __uint_as_float(w & 0xffff0000u); }
__device__ __forceinline__ float ex2(float x) { return __builtin_amdgcn_exp2f(x); }
__device__ __forceinline__ float lg2(float x) { return __builtin_amdgcn_logf(x); }
__device__ __forceinline__ float rcpf_(float x) { return __builtin_amdgcn_rcpf(x); }
__device__ __forceinline__ float silu_f(float x) { return x * rcpf_(1.0f + ex2(-x * LOG2E)); }
__device__ __forceinline__ float softplus2(float z) { return fmaxf(z, 0.f) + lg2(1.0f + ex2(-fabsf(z))); }
__device__ __forceinline__ float wave_sum(float v) {
#pragma unroll
    for (int o = 1; o < 64; o <<= 1) v += __shfl_xor(v, o);
    return v;
}
namespace pg8 {
struct EpiIn {
    static constexpr bool PERM = true, AFTER_DRAIN = false;
    unsigned char* P;
    const float* lb;
    __device__ __forceinline__ void operator()(const f32x4 (&acc)[2][2][4][2], const Unit& u, int wr, int wc, int fr, int fq) const {
        const int pn = u.pn;
        size_t off; int ldc = 256, colt = 0, mode = 0; float scl = 1.f;
        if (pn == 0) { off = P_QA; scl = 0.125f; }
        else if (pn == 1) { off = P_KA; }
        else if (pn == 2) { off = P_VA; ldc = 512; }
        else if (pn == 3) { off = P_VA; ldc = 512; colt = 256; }
        else if (pn == 4) { off = P_GA; ldc = 512; mode = 2; }
        else if (pn == 5) { off = P_GA; ldc = 512; colt = 256; mode = 2; }
        else if (pn == 6) { off = P_QB; mode = 2; }
        else if (pn == 7) { off = P_GFB; mode = 3; }
        else if (pn == 8) { off = P_IB; }
        else if (pn == 9) { off = P_GB; mode = 2; }
        else if (pn == 10) { off = P_QC; scl = 0.125f * LOG2E; }
        else if (pn == 11) { off = P_KC; }
        else if (pn == 12) { off = P_VC; }
        else if (pn == 13) { off = P_GC; mode = 2; }
        else { off = P_LRA; ldc = 16; mode = 4; }
        bf16_t* base = (bf16_t*)(P + off);
        const int row0 = u.pm * BM + wr * 64 + fr, cl = wc * 32 + 8 * fq;
        if (mode == 3) {
            bf16_t* kbase = (bf16_t*)(P + P_KB);
#pragma unroll
            for (int bj = 0; bj < 2; ++bj) {
                const f32x4 l0 = *(const f32x4*)(lb + bj * HALF + cl), l1 = *(const f32x4*)(lb + bj * HALF + cl + 4);
                const float lbv[8] = {l0[0], l0[1], l0[2], l0[3], l1[0], l1[1], l1[2], l1[3]};
#pragma unroll
                for (int ai = 0; ai < 2; ++ai)
#pragma unroll
                    for (int m = 0; m < 4; ++m) {
                        const size_t o = (size_t)(row0 + ai * HALF + m * 16) * 256 + cl + bj * HALF;
                        const f32x4 v0 = acc[ai][bj][m][0], v1 = acc[ai][bj][m][1];
                        const float x[8] = {v0[0], v0[1], v0[2], v0[3], v1[0], v1[1], v1[2], v1[3]};
                        float g[8], kk[8];
#pragma unroll
                        for (int j = 0; j < 8; ++j) { const float s = rcpf_(1.0f + ex2(-x[j] * LOG2E)); const float f = lbv[j] + (1.0f - lbv[j]) * s; g[j] = fmaxf(lg2(f), -200.f); kk[j] = (1.0f - lbv[j]) * (1.0f - s); }
                        u32x4 w; w.x = cvt_pk_bf16(g[0], g[1]); w.y = cvt_pk_bf16(g[2], g[3]); w.z = cvt_pk_bf16(g[4], g[5]); w.w = cvt_pk_bf16(g[6], g[7]);
                        *(u32x4*)(base + o) = w;
                        w.x = cvt_pk_bf16(kk[0], kk[1]); w.y = cvt_pk_bf16(kk[2], kk[3]); w.z = cvt_pk_bf16(kk[4], kk[5]); w.w = cvt_pk_bf16(kk[6], kk[7]);
                        *(u32x4*)(kbase + o) = w;
                    }
            }
        } else if (mode == 4) {
            if (wc == 0 && fq < 2) {
#pragma unroll
                for (int ai = 0; ai < 2; ++ai)
#pragma unroll
                    for (int m = 0; m < 4; ++m) {
                        const f32x4 v0 = acc[ai][0][m][0], v1 = acc[ai][0][m][1];
                        u32x4 w; w.x = cvt_pk_bf16(v0[0], v0[1]); w.y = cvt_pk_bf16(v0[2], v0[3]); w.z = cvt_pk_bf16(v1[0], v1[1]); w.w = cvt_pk_bf16(v1[2], v1[3]);
                        *(u32x4*)(base + (size_t)(row0 + ai * HALF + m * 16) * 16 + 8 * fq) = w;
                    }
            }
        } else {
#pragma unroll
            for (int ai = 0; ai < 2; ++ai)
#pragma unroll
                for (int m = 0; m < 4; ++m) {
                    bf16_t* rowp = base + (size_t)(row0 + ai * HALF + m * 16) * ldc + colt + cl;
#pragma unroll
                    for (int bj = 0; bj < 2; ++bj) {
                        f32x4 v0 = acc[ai][bj][m][0], v1 = acc[ai][bj][m][1];
                        if (mode == 2) {
#pragma unroll
                            for (int j = 0; j < 4; ++j) { v0[j] = silu_f(v0[j]); v1[j] = silu_f(v1[j]); }
                        } else { v0 = v0 * scl; v1 = v1 * scl; }
                        u32x4 w; w.x = cvt_pk_bf16(v0[0], v0[1]); w.y = cvt_pk_bf16(v0[2], v0[3]); w.z = cvt_pk_bf16(v1[0], v1[1]); w.w = cvt_pk_bf16(v1[2], v1[3]);
                        *(u32x4*)(rowp + bj * HALF) = w;
                    }
                }
        }
    }
};
typedef _Float16 h2v_ __attribute__((ext_vector_type(2)));
typedef float f2v_ __attribute__((ext_vector_type(2)));
__device__ __forceinline__ unsigned pk_f16(float a, float b) { f2v_ v = {a, b}; return __builtin_bit_cast(unsigned, __builtin_convertvector(v, h2v_)); }
__device__ __forceinline__ float f16_lo(unsigned w) { return (float)__builtin_bit_cast(h2v_, w)[0]; }
__device__ __forceinline__ float f16_hi(unsigned w) { return (float)__builtin_bit_cast(h2v_, w)[1]; }
template <bool XF32, bool LAST>
struct EpiNorm {
    static constexpr bool PERM = true, AFTER_DRAIN = false;
    const float* X32;
    bf16_t* XB;
    const float* gate;
    const float* mod;
    bf16_t* HN; float* OUT;
    float* part;
    unsigned* cnt;
    __device__ __forceinline__ void operator()(f32x4 (&acc)[2][2][4][2], const Unit& u, int wr, int wc, int fr_, int fq_) const {
        int ln_ = fq_ * 16 + fr_; asm volatile("" : "+v"(ln_));
        const int fr = ln_ & 15, fq = ln_ >> 4;
        const int row0 = u.pm * BM + wr * 64 + fr, col0 = u.pn * BM + wc * 32 + 8 * fq, b = u.pm >> 3;
        float ss[2][4];
        {
            const float* gp = gate + (size_t)b * 3072 + col0;
            f32x4 g[2][2];
#pragma unroll
            for (int bj = 0; bj < 2; ++bj) { g[bj][0] = *(const f32x4*)(gp + bj * HALF); g[bj][1] = *(const f32x4*)(gp + bj * HALF + 4); }
#pragma unroll
            for (int ai = 0; ai < 2; ++ai) {
                if constexpr (XF32) {
#pragma unroll
                    for (int mh = 0; mh < 2; ++mh) {
                        f32x4 xo[2][2][2];
#pragma unroll
                        for (int m2 = 0; m2 < 2; ++m2)
#pragma unroll
                            for (int bj = 0; bj < 2; ++bj) { const float* xp = X32 + (size_t)(row0 + ai * HALF + (2 * mh + m2) * 16) * D + col0 + bj * HALF; xo[m2][bj][0] = *(const f32x4*)xp; xo[m2][bj][1] = *(const f32x4*)(xp + 4); }
#pragma unroll
                        for (int m2 = 0; m2 < 2; ++m2) { const int m = 2 * mh + m2; float s = 0.f;
#pragma unroll
                            for (int bj = 0; bj < 2; ++bj) {
                                const f32x4 v0 = xo[m2][bj][0] + g[bj][0] * acc[ai][bj][m][0], v1 = xo[m2][bj][1] + g[bj][1] * acc[ai][bj][m][1];
                                acc[ai][bj][m][0] = v0; acc[ai][bj][m][1] = v1;
                                s += (v0[0] * v0[0] + v0[1] * v0[1]) + (v0[2] * v0[2] + v0[3] * v0[3]) + (v1[0] * v1[0] + v1[1] * v1[1]) + (v1[2] * v1[2] + v1[3] * v1[3]);
                                if constexpr (!LAST) { u32x4 w; w.x = pk_f16(v0[0], v0[1]); w.y = pk_f16(v0[2], v0[3]); w.z = pk_f16(v1[0], v1[1]); w.w = pk_f16(v1[2], v1[3]);
                                    *(u32x4*)(XB + (size_t)(row0 + ai * HALF + m * 16) * D + col0 + bj * HALF) = w; }
                            }
                            ss[ai][m] = s; }
                    }
                } else {
                    u32x4 xo[4][2];
#pragma unroll
                    for (int m = 0; m < 4; ++m)
#pragma unroll
                        for (int bj = 0; bj < 2; ++bj) xo[m][bj] = *(const u32x4*)(XB + (size_t)(row0 + ai * HALF + m * 16) * D + col0 + bj * HALF);
#pragma unroll
                    for (int m = 0; m < 4; ++m) { float s = 0.f;
#pragma unroll
                        for (int bj = 0; bj < 2; ++bj) {
                            const u32x4 x = xo[m][bj];
                            const f32x4 x0 = {f16_lo(x.x), f16_hi(x.x), f16_lo(x.y), f16_hi(x.y)}, x1 = {f16_lo(x.z), f16_hi(x.z), f16_lo(x.w), f16_hi(x.w)};
                            const f32x4 v0 = x0 + g[bj][0] * acc[ai][bj][m][0], v1 = x1 + g[bj][1] * acc[ai][bj][m][1];
                            acc[ai][bj][m][0] = v0; acc[ai][bj][m][1] = v1;
                            s += (v0[0] * v0[0] + v0[1] * v0[1]) + (v0[2] * v0[2] + v0[3] * v0[3]) + (v1[0] * v1[0] + v1[1] * v1[1]) + (v1[2] * v1[2] + v1[3] * v1[3]);
                            if constexpr (!LAST) { u32x4 w; w.x = pk_f16(v0[0], v0[1]); w.y = pk_f16(v0[2], v0[3]); w.z = pk_f16(v1[0], v1[1]); w.w = pk_f16(v1[2], v1[3]);
                                *(u32x4*)(XB + (size_t)(row0 + ai * HALF + m * 16) * D + col0 + bj * HALF) = w; }
                        }
                        ss[ai][m] = s; }
                }
            }
        }
#pragma unroll
        for (int ai = 0; ai < 2; ++ai)
#pragma unroll
            for (int m = 0; m < 4; ++m) { float s = ss[ai][m]; s += __shfl_xor(s, 16); s += __shfl_xor(s, 32);
                if (fq == 0) __hip_atomic_store(part + (size_t)(row0 + ai * HALF + m * 16) * 16 + u.pn * 4 + wc, s, __ATOMIC_RELAXED, __HIP_MEMORY_SCOPE_AGENT); }
        asm volatile("s_waitcnt vmcnt(0)" ::: "memory");
        __syncthreads();
        if (wr == 0 && wc == 0 && fr == 0 && fq == 0) {
            unsigned* c = cnt + u.pm * 16;
            (void)__hip_atomic_fetch_add(c, 1u, __ATOMIC_RELAXED, __HIP_MEMORY_SCOPE_AGENT);
            unsigned sp = 0;
            while (__hip_atomic_load(c, __ATOMIC_RELAXED, __HIP_MEMORY_SCOPE_AGENT) < 4u) { __builtin_amdgcn_s_sleep(1); if (++sp > (1u << 22)) break; }
        }
        asm volatile("" ::: "memory");
        __syncthreads();
        float rstd[2][4];
#pragma unroll
        for (int ai = 0; ai < 2; ++ai)
#pragma unroll
            for (int m = 0; m < 4; ++m) { unsigned long long* p = (unsigned long long*)(part + (size_t)(row0 + ai * HALF + m * 16) * 16 + 4 * fq);
                const unsigned long long q0 = __hip_atomic_load(p, __ATOMIC_RELAXED, __HIP_MEMORY_SCOPE_AGENT), q1 = __hip_atomic_load(p + 1, __ATOMIC_RELAXED, __HIP_MEMORY_SCOPE_AGENT);
                float s = (__builtin_bit_cast(float, (unsigned)q0) + __builtin_bit_cast(float, (unsigned)(q0 >> 32))) + (__builtin_bit_cast(float, (unsigned)q1) + __builtin_bit_cast(float, (unsigned)(q1 >> 32)));
                s += __shfl_xor(s, 16); s += __shfl_xor(s, 32);
                rstd[ai][m] = __builtin_amdgcn_rsqf(s * (1.f / D) + EPS); }
#pragma unroll
        for (int bj = 0; bj < 2; ++bj) {
            if constexpr (LAST) {
                const f32x4 w0 = *(const f32x4*)(mod + col0 + bj * HALF), w1 = *(const f32x4*)(mod + col0 + bj * HALF + 4);
                float* op = OUT + (size_t)row0 * D + col0 + bj * HALF;
#pragma unroll
                for (int ai = 0; ai < 2; ++ai)
#pragma unroll
                    for (int m = 0; m < 4; ++m) { const float r = rstd[ai][m];
                        *(f32x4*)(op + (size_t)(ai * HALF + m * 16) * D) = acc[ai][bj][m][0] * r * w0; *(f32x4*)(op + (size_t)(ai * HALF + m * 16) * D + 4) = acc[ai][bj][m][1] * r * w1; __builtin_amdgcn_sched_barrier(0); }
            } else {
                const float* mp = mod + (size_t)b * 3072 + col0 + bj * HALF;
                const f32x4 sh0 = *(const f32x4*)mp, sh1 = *(const f32x4*)(mp + 4), sc0 = *(const f32x4*)(mp + 1024) + 1.0f, sc1 = *(const f32x4*)(mp + 1028) + 1.0f;
#pragma unroll
                for (int ai = 0; ai < 2; ++ai)
#pragma unroll
                    for (int m = 0; m < 4; ++m) {
                        const f32x4 h0 = acc[ai][bj][m][0] * rstd[ai][m] * sc0 + sh0, h1 = acc[ai][bj][m][1] * rstd[ai][m] * sc1 + sh1;
                        u32x4 w; w.x = cvt_pk_bf16(h0[0], h0[1]); w.y = cvt_pk_bf16(h0[2], h0[3]); w.z = cvt_pk_bf16(h1[0], h1[1]); w.w = cvt_pk_bf16(h1[2], h1[3]);
                        *(u32x4*)(HN + (size_t)(row0 + ai * HALF + m * 16) * D + col0 + bj * HALF) = w;
                    }
            }
        }
    }
};
}
#define XB_TMO      128
#define XB_XCNT(j)  (256  + 64 * (j))
#define XB_XSUB(j)  (1280 + 64 * (j))
#define XB_XGEN(j)  (2304 + 64 * (j))
#define XB_TOP      3328
#define XB_TOPGEN   3392
#define XCD_BAR_WORDS 3456
#define XB_SPIN_CAP (1u << 18)

__device__ __forceinline__ unsigned xb_ld(unsigned* p)              { return __hip_atomic_load(p, __ATOMIC_RELAXED, __HIP_MEMORY_SCOPE_AGENT); }
__device__ __forceinline__ unsigned xb_add(unsigned* p, unsigned v) { return __hip_atomic_fetch_add(p, v, __ATOMIC_RELAXED, __HIP_MEMORY_SCOPE_AGENT); }
__device__ __forceinline__ unsigned xb_xcc_id() { return (unsigned)__builtin_amdgcn_s_getreg((3 << 11) | 20) & 0xFu; }
#define XB_SPIN(cond, bar) do { unsigned _sp = 0; while (cond) { __builtin_amdgcn_s_sleep(1); \
    if ((++_sp & 255u) == 0u) { if (xb_ld(&(bar)[XB_TMO])) break; if (_sp > XB_SPIN_CAP) { atomicAdd(&(bar)[XB_TMO], 1u); break; } } } } while (0)

struct XcdBarrier {
    unsigned* bar; unsigned x; unsigned w;
    volatile LAS unsigned* st;
};

__device__ __forceinline__ XcdBarrier xcd_barrier_post(unsigned* bar, volatile LAS unsigned* st) {
    XcdBarrier b; b.bar = bar; b.x = xb_xcc_id(); b.st = st;
    if (threadIdx.x == 0) (void)xb_add(&bar[XB_XCNT(b.x)], 1u);
    b.w = (unsigned)__builtin_amdgcn_readfirstlane((int)(threadIdx.x >> 6));
    return b;
}
__device__ __forceinline__ void xcd_barrier_complete(unsigned* bar, unsigned x, unsigned& nloc, unsigned& nx) {
    const unsigned G = gridDim.x * gridDim.y * gridDim.z;
    unsigned sum, cnt, mine, sp = 0u;
    for (;;) {
        sum = 0u; cnt = 0u; mine = 0u;
#pragma unroll
        for (unsigned j = 0; j < 16; ++j) { const unsigned c = xb_ld(&bar[XB_XCNT(j)]); sum += c; cnt += (c > 0u) ? 1u : 0u; mine = (j == x) ? c : mine; }
        if (sum == G) break;
        __builtin_amdgcn_s_sleep(1);
        if ((++sp & 255u) == 0u) { if (xb_ld(&bar[XB_TMO])) break; if (sp > XB_SPIN_CAP) { atomicAdd(&bar[XB_TMO], 1u); break; } }
    }
    nloc = mine > 0u ? mine : 1u; nx = cnt > 0u ? cnt : 1u;
}

__device__ __forceinline__ void xcd_barrier(const XcdBarrier& b) {
    asm volatile("s_waitcnt vmcnt(0)" ::: "memory");
    __syncthreads();
    if (b.w == 0u && pg8::hw_lane() == 0) {
        unsigned* bar = b.bar;
        __builtin_amdgcn_s_waitcnt(0);
        unsigned nloc = b.st[0], nx = b.st[1];
        if (nloc == 0u) { xcd_barrier_complete(bar, b.x, nloc, nx); b.st[0] = nloc; b.st[1] = nx; }
        const unsigned old = xb_add(&bar[XB_XSUB(b.x)], 1u);
        const unsigned gen = old / nloc;
        if (old + 1u == (gen + 1u) * nloc) {
            __builtin_amdgcn_fence(__ATOMIC_RELEASE, "agent");
            asm volatile("s_waitcnt vmcnt(0)" ::: "memory");
            const unsigned og = xb_add(&bar[XB_TOP], 1u);
            const unsigned tg = og / nx;
            if (og + 1u == (tg + 1u) * nx) xb_add(&bar[XB_TOPGEN], 1u);
            else XB_SPIN(xb_ld(&bar[XB_TOPGEN]) == tg, bar);
            __builtin_amdgcn_fence(__ATOMIC_ACQUIRE, "agent");
            xb_add(&bar[XB_XGEN(b.x)], 1u);
            asm volatile("s_waitcnt vmcnt(0)" ::: "memory");
        } else {
            XB_SPIN(xb_ld(&bar[XB_XGEN(b.x)]) == gen, bar);
            __builtin_amdgcn_fence(__ATOMIC_ACQUIRE, "agent");
            asm volatile("s_waitcnt vmcnt(0)" ::: "memory");
        }
    }
    __syncthreads();
}
__device__ __forceinline__ int win_src_col(int c) { return c < 1024 ? c : (c < 3584 ? c + 16 : (c < 3600 ? c - 3584 + 1024 : -1)); }
__device__ __forceinline__ void p0_transpose_item(const float* W, int K, int Nsrc, int nblk, bool winmap, bf16* WT, LAS float* scr, int item, int lane) {
    const int kb = item / nblk, nb = item % nblk, k0 = 64 * kb, n0 = 32 * nb;
    const int kr = lane >> 3, c4 = 4 * (lane & 7); int sc = n0 + c4; if (winmap) sc = win_src_col(sc);
#pragma unroll
    for (int i = 0; i < 8; ++i) { const int kk = 8 * i + kr; const f32x4 v = sc >= 0 ? *(const f32x4*)(W + (size_t)(k0 + kk) * Nsrc + sc) : (f32x4){0.f, 0.f, 0.f, 0.f};
        LAS float* sp = scr + kk * 33 + c4; sp[0] = v.x; sp[1] = v.y; sp[2] = v.z; sp[3] = v.w; }
    LDS_WAIT(); asm volatile("" ::: "memory");
    const int c = lane & 7;
#pragma unroll
    for (int j = 0; j < 4; ++j) { const int n = (lane >> 3) + 8 * j; const LAS float* s = scr + (8 * c) * 33 + n;
        v4u o; o.x = pg8::cvt_pk_bf16(s[0 * 33], s[1 * 33]); o.y = pg8::cvt_pk_bf16(s[2 * 33], s[3 * 33]); o.z = pg8::cvt_pk_bf16(s[4 * 33], s[5 * 33]); o.w = pg8::cvt_pk_bf16(s[6 * 33], s[7 * 33]);
        *(GAS v4u*)(WT + (size_t)(n0 + n) * K + k0 + 8 * c) = o; }
    LDS_WAIT(); asm volatile("" ::: "memory");
}
__device__ __forceinline__ void p0_tr_load(const float* W, int Nsrc, int nblk, bool winmap, int item, int lane, f32x4 (&v)[8], const float* nwa, const float* nwb) {
    const int kb = item / nblk, nb = item % nblk, k0 = 64 * kb, n0 = 32 * nb;
    const int kr = lane >> 3, c4 = 4 * (lane & 7); int sc = n0 + c4; if (winmap) sc = win_src_col(sc);
#pragma unroll
    for (int i = 0; i < 8; ++i) { const int kk = 8 * i + kr; v[i] = sc >= 0 ? *(const f32x4*)(W + (size_t)(k0 + kk) * Nsrc + sc) : (f32x4){0.f, 0.f, 0.f, 0.f}; }
    if (!winmap) {
#pragma unroll
        for (int i = 0; i < 8; ++i) { const int k = k0 + 8 * i + kr; const float s_ = k < 512 ? nwa[k & 127] : (k < 768 ? nwb[(k - 512) & 63] : 1.0f); v[i] = v[i] * s_; }
    }
}
__device__ __forceinline__ void p0_tr_finish(const f32x4 (&v)[8], int K, int nblk, bf16* WT, LAS float* scr, int item, int lane) {
    const int kb = item / nblk, nb = item % nblk, k0 = 64 * kb, n0 = 32 * nb;
    const int kr = lane >> 3, c4 = 4 * (lane & 7);
#pragma unroll
    for (int i = 0; i < 8; ++i) { const int kk = 8 * i + kr; LAS float* sp = scr + kk * 33 + c4; sp[0] = v[i].x; sp[1] = v[i].y; sp[2] = v[i].z; sp[3] = v[i].w; }
    LDS_WAIT(); asm volatile("" ::: "memory");
    const int c = lane & 7;
#pragma unroll
    for (int j = 0; j < 4; ++j) { const int n = (lane >> 3) + 8 * j; const LAS float* s = scr + (8 * c) * 33 + n;
        v4u o; o.x = pg8::cvt_pk_bf16(s[0 * 33], s[1 * 33]); o.y = pg8::cvt_pk_bf16(s[2 * 33], s[3 * 33]); o.z = pg8::cvt_pk_bf16(s[4 * 33], s[5 * 33]); o.w = pg8::cvt_pk_bf16(s[6 * 33], s[7 * 33]);
        *(GAS v4u*)(WT + (size_t)(n0 + n) * K + k0 + 8 * c) = o; }
    LDS_WAIT(); asm volatile("" ::: "memory");
}
__device__ __forceinline__ void p0_ada_item(const float* c, const float* w_ada, const float* b_ada, float* ADA, LAS float* ldsf, int item, int tid, int wave, int lane) {
    const int l = item / 48, cg = item % 48;
    LAS float* cT = ldsf + wave * (128 * 32);
    { const int b = lane & 31, kh = lane >> 5;
#pragma unroll 16
      for (int i = 0; i < 64; ++i) { const int kk = 2 * i + kh; cT[kk * 32 + b] = silu_f(c[b * 1024 + 128 * wave + kk]); } }
    LDS_WAIT(); asm volatile("" ::: "memory");
    float acc[32];
#pragma unroll
    for (int b = 0; b < 32; ++b) acc[b] = 0.f;
    const float* wp = w_ada + ((size_t)l * 1024 + 128 * wave) * 3072 + cg * 64 + lane;
    float wc[32], wn[32];
#pragma unroll
    for (int j = 0; j < 32; ++j) wc[j] = wp[(size_t)j * 3072];
    for (int g = 0; g < 4; ++g) {
        if (g < 3) {
#pragma unroll
            for (int j = 0; j < 32; ++j) wn[j] = wp[(size_t)(32 * (g + 1) + j) * 3072];
        }
#pragma unroll
        for (int j = 0; j < 32; ++j) { const int kk = 32 * g + j; const float w = wc[j];
#pragma unroll
            for (int b4 = 0; b4 < 8; ++b4) { const f32x4 cv = *(const LAS f32x4*)(cT + kk * 32 + 4 * b4);
                acc[4 * b4] += cv.x * w; acc[4 * b4 + 1] += cv.y * w; acc[4 * b4 + 2] += cv.z * w; acc[4 * b4 + 3] += cv.w * w; } }
#pragma unroll
        for (int j = 0; j < 32; ++j) wc[j] = wn[j];
    }
    __syncthreads();
#pragma unroll
    for (int b = 0; b < 32; ++b) ldsf[(wave * 32 + b) * 64 + lane] = acc[b];
    __syncthreads();
#pragma unroll
    for (int j = 0; j < 4; ++j) { const int o = tid + 512 * j, b = o >> 6, col = o & 63; float s = b_ada[l * 3072 + cg * 64 + col];
#pragma unroll
        for (int w = 0; w < 8; ++w) s += ldsf[(w * 32 + b) * 64 + col];
        ADA[((size_t)l * 32 + b) * 3072 + cg * 64 + col] = s; }
    __syncthreads();
}
typedef float f32x2v_ __attribute__((ext_vector_type(2)));
typedef _Float16 half2_t __attribute__((ext_vector_type(2)));
__device__ __forceinline__ unsigned pk_h2(float a, float b) { f32x2v_ v = {a, b}; return __builtin_bit_cast(unsigned, __builtin_convertvector(v, half2_t)); }
__device__ __forceinline__ float h_lo(unsigned w) { return (float)__builtin_bit_cast(half2_t, w)[0]; }
__device__ __forceinline__ float h_hi(unsigned w) { return (float)__builtin_bit_cast(half2_t, w)[1]; }
template <bool FIRST, bool FINAL, bool XF32>
__device__ __forceinline__ void row_pass(const float* xsrc, const bf16* xbsrc, const bf16* Y, const float* gate_prev, const float* ada_l, const float* fw, float* outf, bf16* xbdst, bf16* HN, int gw, int NGW, int lane) {
    for (int m0 = 2 * gw; m0 < M; m0 += 2 * NGW) {
        f32x4 v[2][4]; float s[2];
#pragma unroll
        for (int r = 0; r < 2; ++r) {
            const int m = m0 + r; const int b = m >> 11;
            if (XF32) { const f32x4* xr = (const f32x4*)(xsrc + (size_t)m * D) + lane;
#pragma unroll
                for (int j = 0; j < 4; ++j) v[r][j] = xr[64 * j]; }
            else { const v2u* xr = (const v2u*)(xbsrc + (size_t)m * D) + lane;
#pragma unroll
                for (int j = 0; j < 4; ++j) { const v2u w = xr[64 * j]; v[r][j] = (f32x4){h_lo(w.x), h_hi(w.x), h_lo(w.y), h_hi(w.y)}; } }
            if (!FIRST) {
                const v2u* yr = (const v2u*)(Y + (size_t)m * D) + lane; const f32x4* gp = (const f32x4*)(gate_prev + (size_t)b * 3072) + lane;
#pragma unroll
                for (int j = 0; j < 4; ++j) { const v2u w = yr[64 * j]; const f32x4 g = gp[64 * j]; v[r][j] = v[r][j] + g * (f32x4){bflo(w.x), bfhi(w.x), bflo(w.y), bfhi(w.y)}; }
            }
        }
#pragma unroll
        for (int r = 0; r < 2; ++r) { float a = 0.f;
#pragma unroll
            for (int j = 0; j < 4; ++j) a += (v[r][j].x * v[r][j].x + v[r][j].y * v[r][j].y) + (v[r][j].z * v[r][j].z + v[r][j].w * v[r][j].w);
            s[r] = a; }
#pragma unroll
        for (int o = 1; o < 64; o <<= 1) { s[0] += __shfl_xor(s[0], o); s[1] += __shfl_xor(s[1], o); }
#pragma unroll
        for (int r = 0; r < 2; ++r) {
            const int m = m0 + r; const int b = m >> 11;
            const float rstd = rsqrtf(s[r] * (1.f / D) + EPS);
            if (FINAL) {
                f32x4* od = (f32x4*)(outf + (size_t)m * D) + lane;
#pragma unroll
                for (int j = 0; j < 4; ++j) od[64 * j] = v[r][j] * rstd * ((const f32x4*)fw)[lane + 64 * j];
            } else {
                if (!FIRST) { v2u* od = (v2u*)(xbdst + (size_t)m * D) + lane;
#pragma unroll
                    for (int j = 0; j < 4; ++j) { v2u w; w.x = pk_h2(v[r][j].x, v[r][j].y); w.y = pk_h2(v[r][j].z, v[r][j].w); od[64 * j] = w; } }
                const f32x4* sh = (const f32x4*)(ada_l + (size_t)b * 3072) + lane; const f32x4* sc = (const f32x4*)(ada_l + (size_t)b * 3072 + 1024) + lane;
                v2u* o8 = (v2u*)(HN + (size_t)m * D) + lane;
#pragma unroll
                for (int j = 0; j < 4; ++j) { const f32x4 h = v[r][j] * rstd * (sc[64 * j] + 1.0f) + sh[64 * j]; v2u w; w.x = pg8::cvt_pk_bf16(h.x, h.y); w.y = pg8::cvt_pk_bf16(h.z, h.w); o8[64 * j] = w; }
            }
        }
    }
}
template <int DV, bool GLA>
__device__ __forceinline__ void scan_unit_valu(LAS unsigned char* lds, int b, int h, const bf16* Qs, const bf16* Ks, const bf16* Gs, const bf16* Vs, const bf16* Gate, const bf16* LRA,
                                               const float* w2, const float* bg, const float* normw, bf16* O, int ocol0, int tid) {
    constexpr int TPC = 512 / DV, DPT = 64 / TPC, OP = DV + 4;
    LAS float* qs = (LAS float*)lds; LAS float* ks = qs + 4096; LAS float* es = ks + 4096; LAS float* vs = es + 4096; LAS float* ob = vs + 64 * DV; LAS float* w2s = ob + 64 * OP;
    const int v = tid / TPC, dq = tid % TPC, d0 = dq * DPT;
    float S[DPT];
#pragma unroll
    for (int i = 0; i < DPT; ++i) S[i] = 0.f;
    if (GLA) { for (int i = tid; i < 1024; i += NTHR) w2s[i] = w2[(i >> 6) * 256 + h * 64 + (i & 63)]; if (tid < 64) w2s[1024 + tid] = bg[h * 64 + tid]; }
    const int srow = tid >> 3, sseg = tid & 7;
    for (int c = 0; c < T / 64; ++c) {
        const size_t tok0 = (size_t)b * T + 64 * c;
        __syncthreads();
        {
            const size_t ro = (tok0 + srow) * 256 + h * 64 + 8 * sseg;
            const v4u qv = *(const v4u*)(Qs + ro), kv = *(const v4u*)(Ks + ro);
            LAS float* qd = qs + srow * 64 + 8 * sseg; LAS float* kd = ks + srow * 64 + 8 * sseg; LAS float* ed = es + srow * 64 + 8 * sseg;
            qd[0] = bflo(qv.x); qd[1] = bfhi(qv.x); qd[2] = bflo(qv.y); qd[3] = bfhi(qv.y); qd[4] = bflo(qv.z); qd[5] = bfhi(qv.z); qd[6] = bflo(qv.w); qd[7] = bfhi(qv.w);
            kd[0] = bflo(kv.x); kd[1] = bfhi(kv.x); kd[2] = bflo(kv.y); kd[3] = bfhi(kv.y); kd[4] = bflo(kv.z); kd[5] = bfhi(kv.z); kd[6] = bflo(kv.w); kd[7] = bfhi(kv.w);
            if (GLA) {
                const v4u l0 = *(const v4u*)(LRA + (tok0 + srow) * 16), l1 = *(const v4u*)(LRA + (tok0 + srow) * 16 + 8);
                const float lr[16] = {bflo(l0.x), bfhi(l0.x), bflo(l0.y), bfhi(l0.y), bflo(l0.z), bfhi(l0.z), bflo(l0.w), bfhi(l0.w), bflo(l1.x), bfhi(l1.x), bflo(l1.y), bfhi(l1.y), bflo(l1.z), bfhi(l1.z), bflo(l1.w), bfhi(l1.w)};
#pragma unroll
                for (int j = 0; j < 8; ++j) { float z = w2s[1024 + 8 * sseg + j];
#pragma unroll
                    for (int r = 0; r < 16; ++r) z += lr[r] * w2s[r * 64 + 8 * sseg + j];
                    ed[j] = ex2(-softplus2(-z * LOG2E) * (1.0f / 16.0f)); }
            } else {
                const v4u gv = *(const v4u*)(Gs + ro);
                ed[0] = ex2(bflo(gv.x)); ed[1] = ex2(bfhi(gv.x)); ed[2] = ex2(bflo(gv.y)); ed[3] = ex2(bfhi(gv.y)); ed[4] = ex2(bflo(gv.z)); ed[5] = ex2(bfhi(gv.z)); ed[6] = ex2(bflo(gv.w)); ed[7] = ex2(bfhi(gv.w));
            }
            constexpr int VPT = DV / 8;
            const size_t vo = (tok0 + srow) * (size_t)(4 * DV) + h * DV + VPT * sseg;
            LAS float* vd = vs + srow * DV + VPT * sseg;
#pragma unroll
            for (int q8 = 0; q8 < VPT / 8; ++q8) { const v4u vv = *(const v4u*)(Vs + vo + 8 * q8);
                vd[8 * q8 + 0] = bflo(vv.x); vd[8 * q8 + 1] = bfhi(vv.x); vd[8 * q8 + 2] = bflo(vv.y); vd[8 * q8 + 3] = bfhi(vv.y); vd[8 * q8 + 4] = bflo(vv.z); vd[8 * q8 + 5] = bfhi(vv.z); vd[8 * q8 + 6] = bflo(vv.w); vd[8 * q8 + 7] = bfhi(vv.w); }
        }
        __syncthreads();
        for (int tt = 0; tt < 64; ++tt) {
            const float vv = vs[tt * DV + v]; float a = 0.f;
#pragma unroll
            for (int i4 = 0; i4 < DPT / 4; ++i4) {
                const f32x4 q4 = *(const LAS f32x4*)(qs + tt * 64 + d0 + 4 * i4), k4 = *(const LAS f32x4*)(ks + tt * 64 + d0 + 4 * i4), e4 = *(const LAS f32x4*)(es + tt * 64 + d0 + 4 * i4);
#pragma unroll
                for (int j = 0; j < 4; ++j) { S[4 * i4 + j] = e4[j] * S[4 * i4 + j] + k4[j] * vv; a += q4[j] * S[4 * i4 + j]; }
            }
#pragma unroll
            for (int o = 1; o < TPC; o <<= 1) a += __shfl_xor(a, o);
            if (dq == 0) ob[tt * OP + v] = a;
        }
        __syncthreads();
        {
            constexpr int CPT = DV / 8;
            const LAS float* orow = ob + srow * OP + CPT * sseg; float x[CPT]; float ss = 0.f;
#pragma unroll
            for (int j = 0; j < CPT; ++j) { x[j] = orow[j]; ss += x[j] * x[j]; }
            ss += __shfl_xor(ss, 1); ss += __shfl_xor(ss, 2); ss += __shfl_xor(ss, 4);
            const float rstd = rsqrtf(ss * (1.0f / DV) + EPS);
            const size_t go = (tok0 + srow) * (size_t)(4 * DV) + h * DV + CPT * sseg;
            bf16* op = O + (tok0 + srow) * (size_t)D + ocol0 + h * DV + CPT * sseg;
#pragma unroll
            for (int q8 = 0; q8 < CPT / 8; ++q8) { const v4u gg = *(const v4u*)(Gate + go + 8 * q8); const float* nw = normw + CPT * sseg + 8 * q8;
                const float gt[8] = {bflo(gg.x), bfhi(gg.x), bflo(gg.y), bfhi(gg.y), bflo(gg.z), bfhi(gg.z), bflo(gg.w), bfhi(gg.w)}; float y[8];
#pragma unroll
                for (int j = 0; j < 8; ++j) y[j] = x[8 * q8 + j] * rstd * nw[j] * gt[j];
                v4u w; w.x = pk2(y[0], y[1]); w.y = pk2(y[2], y[3]); w.z = pk2(y[4], y[5]); w.w = pk2(y[6], y[7]); *(v4u*)(op + 8 * q8) = w; }
        }
    }
    __syncthreads();
}
__device__ __forceinline__ void sb_unit_valu(LAS unsigned char* lds, int b, int h, int qb, const bf16* QC, const bf16* KC, const bf16* VC, const bf16* GC, bf16* O, int tid, int wave) {
    LAS float* Ks = (LAS float*)lds; LAS float* Vs = Ks + 4096;
    const int t0 = qb * 512, t = t0 + tid; const size_t rowq = ((size_t)b * T + t) * 256 + h * 64;
    float q[64], o[64];
#pragma unroll
    for (int i = 0; i < 8; ++i) { const v4u w = *(const v4u*)(QC + rowq + 8 * i); q[8 * i] = bflo(w.x); q[8 * i + 1] = bfhi(w.x); q[8 * i + 2] = bflo(w.y); q[8 * i + 3] = bfhi(w.y); q[8 * i + 4] = bflo(w.z); q[8 * i + 5] = bfhi(w.z); q[8 * i + 6] = bflo(w.w); q[8 * i + 7] = bfhi(w.w); }
#pragma unroll
    for (int i = 0; i < 64; ++i) o[i] = 0.f;
    float carry = 0.f; int wdone = 0; const int wt_max = t0 + 64 * wave + 63; const int srow = tid >> 3, sseg = tid & 7;
    for (int kt = qb * 8 + 7; kt >= 0; --kt) {
        { volatile LAS unsigned* fl = (volatile LAS unsigned*)(lds + LDSCTL_OFF); if ((tid & 63) == 0) fl[wave] = (unsigned)wdone; __syncthreads();
          const unsigned all = fl[0] & fl[1] & fl[2] & fl[3] & fl[4] & fl[5] & fl[6] & fl[7]; if (all) break; }
        { const size_t ro = ((size_t)b * T + 64 * kt + srow) * 256 + h * 64 + 8 * sseg; const v4u kv = *(const v4u*)(KC + ro), vv = *(const v4u*)(VC + ro);
          LAS float* kd = Ks + srow * 64 + 8 * sseg; LAS float* vd = Vs + srow * 64 + 8 * sseg;
          kd[0] = bflo(kv.x); kd[1] = bfhi(kv.x); kd[2] = bflo(kv.y); kd[3] = bfhi(kv.y); kd[4] = bflo(kv.z); kd[5] = bfhi(kv.z); kd[6] = bflo(kv.w); kd[7] = bfhi(kv.w);
          vd[0] = bflo(vv.x); vd[1] = bfhi(vv.x); vd[2] = bflo(vv.y); vd[3] = bfhi(vv.y); vd[4] = bflo(vv.z); vd[5] = bfhi(vv.z); vd[6] = bflo(vv.w); vd[7] = bfhi(vv.w); }
        __syncthreads();
        if (!wdone && 64 * kt < wt_max) {
            const int jhi = min(63, wt_max - 1 - 64 * kt);
            for (int j = jhi; j >= 0; --j) {
                const int s = 64 * kt + j; float z = 0.f;
#pragma unroll
                for (int i = 0; i < 16; ++i) { const f32x4 k4 = *(const LAS f32x4*)(Ks + j * 64 + 4 * i); z += q[4 * i] * k4[0] + q[4 * i + 1] * k4[1] + q[4 * i + 2] * k4[2] + q[4 * i + 3] * k4[3]; }
                const float sp = softplus2(z); const bool valid = s < t;
                const float w = valid ? ex2(z - sp + carry) : 0.f;
                carry += valid ? -sp : 0.f;
#pragma unroll
                for (int i = 0; i < 16; ++i) { const f32x4 v4 = *(const LAS f32x4*)(Vs + j * 64 + 4 * i); o[4 * i] += w * v4[0]; o[4 * i + 1] += w * v4[1]; o[4 * i + 2] += w * v4[2]; o[4 * i + 3] += w * v4[3]; }
            }
            wdone = __all(carry < -150.f) ? 1 : 0;
        }
    }
    __syncthreads();
    bf16* op = O + ((size_t)b * T + t) * D + 768 + h * 64;
#pragma unroll
    for (int i = 0; i < 8; ++i) { const v4u gg = *(const v4u*)(GC + rowq + 8 * i); v4u w;
        w.x = pk2(o[8 * i] * bflo(gg.x), o[8 * i + 1] * bfhi(gg.x)); w.y = pk2(o[8 * i + 2] * bflo(gg.y), o[8 * i + 3] * bfhi(gg.y));
        w.z = pk2(o[8 * i + 4] * bflo(gg.z), o[8 * i + 5] * bfhi(gg.z)); w.w = pk2(o[8 * i + 6] * bflo(gg.w), o[8 * i + 7] * bfhi(gg.w)); *(v4u*)(op + 8 * i) = w; }
}
typedef short bf16x8_t __attribute__((ext_vector_type(8)));
typedef short v4i16_t __attribute__((ext_vector_type(4)));
typedef float f32x16 __attribute__((ext_vector_type(16)));
#define MFMA32(a, b, c) __builtin_amdgcn_mfma_f32_32x32x16_bf16((a), (b), (c), 0, 0, 0)
constexpr int SB_PITCH = 144, SB_NK = 384;
constexpr float SB_THR = 3.552713678800501e-15f;
__device__ __forceinline__ int crow16(int i, int hi) { return (i & 3) + 8 * (i >> 2) + 4 * hi; }
template <bool MASK>
__device__ __forceinline__ void sb_block(const f32x16& p, int key0, int row, int hi, float& carry, v4u& w0, v4u& w1) {
    float be[16], om[16];
#pragma unroll
    for (int i = 0; i < 16; ++i) {
        float nz = -p[i];
        if (MASK) nz = ((key0 + crow16(i, hi)) < row) ? nz : __builtin_inff();
        const float e = ex2(__builtin_amdgcn_fmed3f(nz, -3.0e38f, 126.f)), r = rcpf_(1.0f + e);
        be[i] = r; om[i] = e * r;
    }
    float glo[4], ghi[4];
#pragma unroll
    for (int j = 0; j < 4; ++j) { const float g = (om[4 * j] * om[4 * j + 1]) * (om[4 * j + 2] * om[4 * j + 3]);
        const auto rr = __builtin_amdgcn_permlane32_swap(__float_as_uint(g), __float_as_uint(g), false, false); glo[j] = __uint_as_float(rr[0]); ghi[j] = __uint_as_float(rr[1]); }
    float run = carry, w[16];
#pragma unroll
    for (int j = 3; j >= 0; --j) {
        const float e1 = run; run *= ghi[j]; const float e0 = run; run *= glo[j];
        float bt = hi ? e1 : e0;
        w[4 * j + 3] = be[4 * j + 3] * bt; bt *= om[4 * j + 3];
        w[4 * j + 2] = be[4 * j + 2] * bt; bt *= om[4 * j + 2];
        w[4 * j + 1] = be[4 * j + 1] * bt; bt *= om[4 * j + 1];
        w[4 * j] = be[4 * j] * bt;
    }
    carry = run;
    w0.x = pg8::cvt_pk_bf16(w[0], w[1]); w0.y = pg8::cvt_pk_bf16(w[2], w[3]); w0.z = pg8::cvt_pk_bf16(w[4], w[5]); w0.w = pg8::cvt_pk_bf16(w[6], w[7]);
    w1.x = pg8::cvt_pk_bf16(w[8], w[9]); w1.y = pg8::cvt_pk_bf16(w[10], w[11]); w1.z = pg8::cvt_pk_bf16(w[12], w[13]); w1.w = pg8::cvt_pk_bf16(w[14], w[15]);
}
__device__ __forceinline__ bf16x8_t sb_vfrag(const LAS unsigned char* Vl, int rowbase, int s, int c, int lane) {
    const int hi = lane >> 5, blk = (lane >> 4) & 1, i16 = lane & 15;
    const LAS unsigned char* p = Vl + (rowbase + 16 * s + 4 * hi + (i16 >> 2)) * SB_PITCH + (32 * c + 16 * blk + 4 * (i16 & 3)) * 2;
    const v4i16_t lo = __builtin_amdgcn_ds_read_tr16_b64_v4i16((LAS v4i16_t*)p);
    const v4i16_t hh = __builtin_amdgcn_ds_read_tr16_b64_v4i16((LAS v4i16_t*)(p + 8 * SB_PITCH));
    return (bf16x8_t){lo[0], lo[1], lo[2], lo[3], hh[0], hh[1], hh[2], hh[3]};
}
template <bool MASK>
__device__ __forceinline__ bool sb_tile(const LAS unsigned char* Kl, const LAS unsigned char* Vl, int trow, int key0, int row, bool do_p1, const bf16x8_t (&qf)[4], f32x16& o0, f32x16& o1, float& carry, int lane) {
    const int r32 = lane & 31, hi = lane >> 5;
    f32x16 zero;
#pragma unroll
    for (int i = 0; i < 16; ++i) zero[i] = 0.f;
    if (do_p1) {
        f32x16 p = zero;
#pragma unroll
        for (int ks = 0; ks < 4; ++ks) { const bf16x8_t a = *(const LAS bf16x8_t*)(Kl + (trow + 32 + r32) * SB_PITCH + (16 * ks + 8 * hi) * 2); p = MFMA32(a, qf[ks], p); }
        v4u w0, w1; sb_block<MASK>(p, key0 + 32, row, hi, carry, w0, w1);
        const bf16x8_t a0 = __builtin_bit_cast(bf16x8_t, w0), a1 = __builtin_bit_cast(bf16x8_t, w1);
        o0 = MFMA32(a0, sb_vfrag(Vl, trow + 32, 0, 0, lane), o0); o1 = MFMA32(a0, sb_vfrag(Vl, trow + 32, 0, 1, lane), o1);
        o0 = MFMA32(a1, sb_vfrag(Vl, trow + 32, 1, 0, lane), o0); o1 = MFMA32(a1, sb_vfrag(Vl, trow + 32, 1, 1, lane), o1);
        if (__all(carry < SB_THR)) return true;
    }
    {
        f32x16 p = zero;
#pragma unroll
        for (int ks = 0; ks < 4; ++ks) { const bf16x8_t a = *(const LAS bf16x8_t*)(Kl + (trow + r32) * SB_PITCH + (16 * ks + 8 * hi) * 2); p = MFMA32(a, qf[ks], p); }
        v4u w0, w1; sb_block<MASK>(p, key0, row, hi, carry, w0, w1);
        const bf16x8_t a0 = __builtin_bit_cast(bf16x8_t, w0), a1 = __builtin_bit_cast(bf16x8_t, w1);
        o0 = MFMA32(a0, sb_vfrag(Vl, trow, 0, 0, lane), o0); o1 = MFMA32(a0, sb_vfrag(Vl, trow, 0, 1, lane), o1);
        o0 = MFMA32(a1, sb_vfrag(Vl, trow, 1, 0, lane), o0); o1 = MFMA32(a1, sb_vfrag(Vl, trow, 1, 1, lane), o1);
    }
    return __all(carry < SB_THR);
}
__device__ __forceinline__ void sb_unit_mfma(LAS unsigned char* lds, int b, int h, int qb, const bf16* QC, const bf16* KC, const bf16* VC, const bf16* GC, bf16* O, int tid, int wave) {
    const int lane = tid & 63, r32 = lane & 31, hi = lane >> 5;
    LAS unsigned char* Kl = lds; LAS unsigned char* Vl = lds + SB_NK * SB_PITCH;
    volatile LAS unsigned* fl = (volatile LAS unsigned*)(lds + LDSCTL_OFF);
    const int q0 = qb * 256, qw = q0 + 32 * wave, row = qw + r32;
    const size_t tokb = (size_t)b * T;
    bf16x8_t qf[4];
#pragma unroll
    for (int ks = 0; ks < 4; ++ks) qf[ks] = *(const bf16x8_t*)(QC + (tokb + row) * 256 + h * 64 + 16 * ks + 8 * hi);
    f32x16 o0, o1;
#pragma unroll
    for (int i = 0; i < 16; ++i) { o0[i] = 0.f; o1[i] = 0.f; }
    float carry = 1.0f; int done = 0;
    int hi_key = q0 + 256, lo_key = hi_key > SB_NK ? hi_key - SB_NK : 0;
    const int kmax = qw + 30, T0 = kmax >> 6;
    for (;;) {
        __syncthreads();
        const int nch = (hi_key - lo_key) * 8;
        for (int cidx = tid; cidx < nch; cidx += NTHR) { const int r = cidx >> 3, ch = cidx & 7; const size_t g = (tokb + lo_key + r) * 256 + h * 64 + 8 * ch;
            *(LAS v4u*)(Kl + r * SB_PITCH + ch * 16) = *(const v4u*)(KC + g); *(LAS v4u*)(Vl + r * SB_PITCH + ch * 16) = *(const v4u*)(VC + g); }
        __syncthreads();
        if (!done) {
            const int Ttop = min(T0, (hi_key - 1) >> 6), Tlo = lo_key >> 6;
            for (int Tt = Ttop; Tt >= Tlo; --Tt) {
                const int key0 = 64 * Tt, trow = key0 - lo_key;
                bool fin;
                if (key0 + 63 >= qw) fin = sb_tile<true>(Kl, Vl, trow, key0, row, key0 + 32 <= kmax, qf, o0, o1, carry, lane);
                else fin = sb_tile<false>(Kl, Vl, trow, key0, row, true, qf, o0, o1, carry, lane);
                if (fin) { done = 1; break; }
            }
        }
        if (lane == 0) fl[wave] = (unsigned)done;
        __syncthreads();
        const unsigned all = fl[0] & fl[1] & fl[2] & fl[3] & fl[4] & fl[5] & fl[6] & fl[7];
        if (all || lo_key == 0) break;
        hi_key = lo_key; lo_key = hi_key > SB_NK ? hi_key - SB_NK : 0;
    }
    {
        LAS float* stg = (LAS float*)(lds + wave * 8704);
#pragma unroll
        for (int i = 0; i < 16; ++i) { stg[crow16(i, hi) * 68 + r32] = o0[i]; stg[crow16(i, hi) * 68 + 32 + r32] = o1[i]; }
        asm volatile("s_waitcnt lgkmcnt(0)" ::: "memory");
        const int rw = lane >> 1, hf = lane & 1; const size_t rr = tokb + qw + rw;
        const bf16* gp = GC + rr * 256 + h * 64 + 32 * hf; bf16* op = O + rr * D + 768 + h * 64 + 32 * hf; const LAS float* sp = stg + rw * 68 + 32 * hf;
#pragma unroll
        for (int q8 = 0; q8 < 4; ++q8) {
            const v4u gg = *(const v4u*)(gp + 8 * q8); const f32x4 a = *(const LAS f32x4*)(sp + 8 * q8), b2 = *(const LAS f32x4*)(sp + 8 * q8 + 4);
            v4u w; w.x = pg8::cvt_pk_bf16(a[0] * bflo(gg.x), a[1] * bfhi(gg.x)); w.y = pg8::cvt_pk_bf16(a[2] * bflo(gg.y), a[3] * bfhi(gg.y));
            w.z = pg8::cvt_pk_bf16(b2[0] * bflo(gg.z), b2[1] * bfhi(gg.z)); w.w = pg8::cvt_pk_bf16(b2[2] * bflo(gg.w), b2[3] * bfhi(gg.w));
            *(v4u*)(op + 8 * q8) = w;
        }
    }
}

#define SB_BARRIER() do { asm volatile("s_waitcnt lgkmcnt(0)" ::: "memory"); __builtin_amdgcn_s_barrier(); asm volatile("" ::: "memory"); } while (0)
__device__ __forceinline__ void sb_units_pipe(LAS unsigned char* lds, int n_units, int u0, int ustride, int uskip, const bf16* QC, const bf16* KC, const bf16* VC, const bf16* GC, bf16* O, int tid, int wave) {
    int tl = tid; asm volatile("" : "+v"(tl));
    int lane = tl & 63, r32 = lane & 31, hi = lane >> 5;
    LAS unsigned char* Kl = lds; LAS unsigned char* Vl = lds + SB_NK * SB_PITCH;
    volatile LAS unsigned* fl = (volatile LAS unsigned*)(lds + LDSCTL_OFF);
    constexpr int NPRE = (SB_NK * 8 + NTHR - 1) / NTHR;
    v4u kpre[NPRE], vpre[NPRE]; bf16x8_t qpre[4];
#define SB_PREFETCH(u_) do { const int bh_ = (u_) & 127, qb_ = 7 - ((u_) >> 7), h_ = bh_ & 3; const size_t tb_ = (size_t)(bh_ >> 2) * T; \
        const int hk_ = qb_ * 256 + 256, lk_ = hk_ > SB_NK ? hk_ - SB_NK : 0, nch_ = (hk_ - lk_) * 8; \
        _Pragma("unroll") for (int j = 0; j < NPRE; ++j) { const int ci_ = tl + NTHR * j; if (ci_ < nch_) { const size_t g_ = (tb_ + lk_ + (ci_ >> 3)) * 256 + h_ * 64 + 8 * (ci_ & 7); kpre[j] = *(const v4u*)(KC + g_); vpre[j] = *(const v4u*)(VC + g_); } } \
        _Pragma("unroll") for (int ks = 0; ks < 4; ++ks) qpre[ks] = *(const bf16x8_t*)(QC + (tb_ + qb_ * 256 + 32 * wave + r32) * 256 + h_ * 64 + 16 * ks + 8 * hi); } while (0)
    if (n_units > 0) SB_PREFETCH(u0);
    for (int iu = 0; iu < n_units; ++iu) {
        tl = tid; asm volatile("" : "+v"(tl)); lane = tl & 63; r32 = lane & 31; hi = lane >> 5;
        const int u = u0 + ustride * iu + (iu ? uskip : 0), bh = u & 127, qb = 7 - (u >> 7), b = bh >> 2, h = bh & 3;
        const int q0 = qb * 256, qw = q0 + 32 * wave, row = qw + r32;
        const size_t tokb = (size_t)b * T;
        int hi_key = q0 + 256, lo_key = hi_key > SB_NK ? hi_key - SB_NK : 0;
        SB_BARRIER();
        { const int nch = (hi_key - lo_key) * 8;
#pragma unroll
          for (int j = 0; j < NPRE; ++j) { const int ci = tl + NTHR * j; if (ci < nch) { *(LAS v4u*)(Kl + (ci >> 3) * SB_PITCH + (ci & 7) * 16) = kpre[j]; *(LAS v4u*)(Vl + (ci >> 3) * SB_PITCH + (ci & 7) * 16) = vpre[j]; } } }
        bf16x8_t qf[4]; v4u gate[4];
#pragma unroll
        for (int ks = 0; ks < 4; ++ks) { qf[ks] = qpre[ks]; gate[ks] = *(const v4u*)(GC + (tokb + qw + (lane >> 1)) * 256 + h * 64 + 32 * (lane & 1) + 8 * ks); }
        SB_BARRIER();
        if (iu + 1 < n_units) SB_PREFETCH(u0 + ustride * (iu + 1) + uskip);
        f32x16 o0, o1;
#pragma unroll
        for (int i = 0; i < 16; ++i) { o0[i] = 0.f; o1[i] = 0.f; }
        float carry = 1.0f; int done = 0;
        const int kmax = qw + 30, T0 = kmax >> 6;
        for (bool first = true;; first = false) {
            if (!first) {
                SB_BARRIER();
                const int nch = (hi_key - lo_key) * 8;
                for (int cidx = tl; cidx < nch; cidx += NTHR) { const int r = cidx >> 3, ch = cidx & 7; const size_t g = (tokb + lo_key + r) * 256 + h * 64 + 8 * ch;
                    *(LAS v4u*)(Kl + r * SB_PITCH + ch * 16) = *(const v4u*)(KC + g); *(LAS v4u*)(Vl + r * SB_PITCH + ch * 16) = *(const v4u*)(VC + g); }
                SB_BARRIER();
            }
            if (!done) {
                const int Ttop = min(T0, (hi_key - 1) >> 6), Tlo = lo_key >> 6;
                for (int Tt = Ttop; Tt >= Tlo; --Tt) {
                    const int key0 = 64 * Tt, trow = key0 - lo_key;
                    bool fin;
                    if (key0 + 63 >= qw) fin = sb_tile<true>(Kl, Vl, trow, key0, row, key0 + 32 <= kmax, qf, o0, o1, carry, lane);
                    else fin = sb_tile<false>(Kl, Vl, trow, key0, row, true, qf, o0, o1, carry, lane);
                    if (fin) { done = 1; break; }
                }
            }
            if (lane == 0) fl[wave] = (unsigned)done;
            SB_BARRIER();
            const unsigned all = fl[0] & fl[1] & fl[2] & fl[3] & fl[4] & fl[5] & fl[6] & fl[7];
            if (all || lo_key == 0) break;
            hi_key = lo_key; lo_key = hi_key > SB_NK ? hi_key - SB_NK : 0;
        }
        {
            LAS float* stg = (LAS float*)(lds + wave * 8704);
#pragma unroll
            for (int i = 0; i < 16; ++i) { stg[crow16(i, hi) * 68 + r32] = o0[i]; stg[crow16(i, hi) * 68 + 32 + r32] = o1[i]; }
            asm volatile("s_waitcnt lgkmcnt(0)" ::: "memory");
            const int rw = lane >> 1, hf = lane & 1; const size_t rr = tokb + qw + rw;
            bf16* op = O + rr * D + 768 + h * 64 + 32 * hf; const LAS float* sp = stg + rw * 68 + 32 * hf;
#pragma unroll
            for (int q8 = 0; q8 < 4; ++q8) {
                const v4u gg = gate[q8]; const f32x4 a = *(const LAS f32x4*)(sp + 8 * q8), b2 = *(const LAS f32x4*)(sp + 8 * q8 + 4);
                v4u w; w.x = pg8::cvt_pk_bf16(a[0] * bflo(gg.x), a[1] * bfhi(gg.x)); w.y = pg8::cvt_pk_bf16(a[2] * bflo(gg.y), a[3] * bfhi(gg.y));
                w.z = pg8::cvt_pk_bf16(b2[0] * bflo(gg.z), b2[1] * bfhi(gg.z)); w.w = pg8::cvt_pk_bf16(b2[2] * bflo(gg.w), b2[3] * bfhi(gg.w));
                *(v4u*)(op + 8 * q8) = w;
            }
        }
    }
#undef SB_PREFETCH
}
constexpr int SC_P = 144;
template <int DV> struct ScanLds {
    static constexpr int VP = DV * 2 + 16, OP = DV + 4;
    static constexpr int QM = 0, KM = QM + 64 * SC_P, Q0 = KM + 64 * SC_P, KET = Q0 + 64 * SC_P, V = KET + 64 * SC_P, DEC = V + 64 * VP, GS = DEC + 256, OB = GS + 2048, END = OB + 64 * OP * 4;
};
__device__ __forceinline__ bf16x8_t tr_frag(const LAS unsigned char* base, int pitch, int row0, int col0, int lane) {
    const int blk = (lane >> 4) & 1, i16 = lane & 15;
    const LAS unsigned char* p = base + (row0 + (i16 >> 2)) * pitch + (col0 + 16 * blk + 4 * (i16 & 3)) * 2;
    const v4i16_t lo = __builtin_amdgcn_ds_read_tr16_b64_v4i16((LAS v4i16_t*)p);
    return (bf16x8_t){lo[0], lo[1], lo[2], lo[3], 0, 0, 0, 0};
}
__device__ __forceinline__ bf16x8_t tr_frag2(const LAS unsigned char* base, int pitch, int rowa, int rowb, int col0, int lane) {
    const int blk = (lane >> 4) & 1, i16 = lane & 15;
    const int co = (col0 + 16 * blk + 4 * (i16 & 3)) * 2;
    const v4i16_t lo = __builtin_amdgcn_ds_read_tr16_b64_v4i16((LAS v4i16_t*)(base + (rowa + (i16 >> 2)) * pitch + co));
    const v4i16_t hh = __builtin_amdgcn_ds_read_tr16_b64_v4i16((LAS v4i16_t*)(base + (rowb + (i16 >> 2)) * pitch + co));
    return (bf16x8_t){lo[0], lo[1], lo[2], lo[3], hh[0], hh[1], hh[2], hh[3]};
}
__device__ __forceinline__ bf16x8_t pack8(const f32x16& x, int s) {
    v4u w; w.x = pg8::cvt_pk_bf16(x[8 * s], x[8 * s + 1]); w.y = pg8::cvt_pk_bf16(x[8 * s + 2], x[8 * s + 3]); w.z = pg8::cvt_pk_bf16(x[8 * s + 4], x[8 * s + 5]); w.w = pg8::cvt_pk_bf16(x[8 * s + 6], x[8 * s + 7]);
    return __builtin_bit_cast(bf16x8_t, w);
}
#define LDS_BARRIER() do { asm volatile("s_waitcnt lgkmcnt(0)" ::: "memory"); __builtin_amdgcn_s_barrier(); asm volatile("" ::: "memory"); } while (0)
template <int DV, bool GLA>
__device__ __forceinline__ void scan_unit_mfma(LAS unsigned char* lds, int b, int h, const bf16* Qs, const bf16* Ks, const bf16* Gs, const bf16* Vs, const bf16* Gate, const bf16* LRA,
                                               const float* w2, const float* bg, const float* normw, bf16* O, int ocol0, int tid, int wave) {
    typedef ScanLds<DV> L;
    constexpr int G2OFF = L::END;
    constexpr int RQ = G2OFF + 16384, RK = RQ + 64 * SC_P, RG = RK + 64 * SC_P;
    static_assert(RG + 64 * SC_P <= RING_BYTES, "scan LDS");
    constexpr int VPT = DV / 8, CPT = DV / 8, NC = T / 64;
    const int lane = tid & 63, r32 = lane & 31, hi = lane >> 5;
    const int ti = wave >> 2, cb = wave & 3; const bool mma_on = (32 * cb < DV);
    LAS float* gsum = (LAS float*)(lds + L::GS); LAS float* dec = (LAS float*)(lds + L::DEC); LAS float* obuf = (LAS float*)(lds + L::OB); LAS float* g2 = (LAS float*)(lds + G2OFF);
    f32x16 S0, S1;
    unsigned cmask[8];
#pragma unroll
    for (int j = 0; j < 8; ++j) cmask[j] = ((crow16(2 * j, hi) <= r32) ? 0x0000FFFFu : 0u) | ((crow16(2 * j + 1, hi) <= r32) ? 0xFFFF0000u : 0u);
#pragma unroll
    for (int i = 0; i < 16; ++i) { S0[i] = 0.f; S1[i] = 0.f; }
    const int srow = tid >> 3, sseg = tid & 7;
    const size_t tokb = (size_t)b * T;
    (void)normw;
    const int gm = (wave >> 1) & 1, gn = wave & 1;
    bf16x8_t w2f = {0, 0, 0, 0, 0, 0, 0, 0}; float gbias = 0.f, gbl2_ = 0.f; v4u lraR = {0u, 0u, 0u, 0u};
    f32x16 zero16;
#pragma unroll
    for (int i = 0; i < 16; ++i) zero16[i] = 0.f;
    if (GLA && wave < 4) {
        v4u w;
        const float* wp = w2 + (8 * hi) * 256 + h * 64 + 32 * gn + r32;
        w.x = pg8::cvt_pk_bf16(wp[0], wp[256]); w.y = pg8::cvt_pk_bf16(wp[512], wp[768]); w.z = pg8::cvt_pk_bf16(wp[1024], wp[1280]); w.w = pg8::cvt_pk_bf16(wp[1536], wp[1792]);
        w2f = __builtin_bit_cast(bf16x8_t, w); gbias = bg[h * 64 + 32 * gn + r32]; gbl2_ = gbias * (-LOG2E);
    }
#define SCAN_GATE_BLOCK(chunk) do {   \
        const f32x16 zz = MFMA32(__builtin_bit_cast(bf16x8_t, lraR), w2f, zero16); \
        _Pragma("unroll") for (int i = 0; i < 16; ++i) g2[(32 * gm + crow16(i, hi)) * 64 + 32 * gn + r32] = lg2(1.0f + ex2(fminf(__builtin_fmaf(zz[i], -LOG2E, gbl2_), 126.f))) * (-1.0f / 16.0f); } while (0)
#define SCAN_LRA_LOAD(chunk) do { lraR = *(const v4u*)(LRA + (tokb + 64 * (chunk) + 32 * gm + r32) * 16 + 8 * hi); } while (0)
    v4u qw_ = {0u, 0u, 0u, 0u}, kw_ = qw_, gw_ = qw_; v4u vraw[VPT / 8], gateR[CPT / 8];
#define SCAN_RAW_LOAD(chunk) do { const size_t t0_ = tokb + 64 * (chunk); \
        { const size_t o_ = (t0_ + srow) * 256 + h * 64 + 8 * sseg; qw_ = *(const v4u*)(Qs + o_); kw_ = *(const v4u*)(Ks + o_); if (!GLA) gw_ = *(const v4u*)(Gs + o_); } \
        _Pragma("unroll") for (int q8 = 0; q8 < VPT / 8; ++q8) vraw[q8] = *(const v4u*)(Vs + (t0_ + srow) * (size_t)(4 * DV) + h * DV + VPT * sseg + 8 * q8); } while (0)
#define SCAN_RAW_TO_LDS() do { *(LAS v4u*)(lds + RQ + srow * SC_P + 16 * sseg) = qw_; *(LAS v4u*)(lds + RK + srow * SC_P + 16 * sseg) = kw_; if (!GLA) *(LAS v4u*)(lds + RG + srow * SC_P + 16 * sseg) = gw_; } while (0)
#define SCAN_GATE_LOAD(chunk) do { _Pragma("unroll") for (int q8 = 0; q8 < CPT / 8; ++q8) gateR[q8] = *(const v4u*)(Gate + (tokb + 64 * (chunk) + srow) * (size_t)(4 * DV) + h * DV + CPT * sseg + 8 * q8); } while (0)
    __syncthreads();
    if (GLA && wave < 4) { SCAN_LRA_LOAD(0); SCAN_GATE_BLOCK(0); SCAN_LRA_LOAD(1); }
    SCAN_RAW_LOAD(0); SCAN_GATE_LOAD(0); SCAN_RAW_TO_LDS();
    { const size_t o_ = (tokb + 64 + srow) * 256 + h * 64 + 8 * sseg; qw_ = *(const v4u*)(Qs + o_); kw_ = *(const v4u*)(Ks + o_); if (!GLA) gw_ = *(const v4u*)(Gs + o_); }
    __syncthreads();
    for (int c = 0; c < NC; ++c) {
        const size_t tok0 = tokb + 64 * c;
        const int cn = c + 1 < NC ? c + 1 : NC - 1, cnn = c + 2 < NC ? c + 2 : NC - 1;
        float g[8];
#pragma unroll
        for (int i = 0; i < 8; ++i) g[i] = GLA ? g2[(8 * wave + i) * 64 + lane] : bflo((unsigned)*(const LAS bf16*)(lds + RG + (8 * wave + i) * SC_P + lane * 2));
#pragma unroll
        for (int i = 1; i < 8; ++i) g[i] += g[i - 1];
        gsum[wave * 64 + lane] = g[7];
#pragma unroll
        for (int q8 = 0; q8 < VPT / 8; ++q8) *(LAS v4u*)(lds + L::V + srow * L::VP + (VPT * sseg + 8 * q8) * 2) = vraw[q8];
        LDS_BARRIER();
        float off = 0.f, bmid = 0.f, ball = 0.f;
#pragma unroll
        for (int w = 0; w < 8; ++w) { const float s = gsum[w * 64 + lane]; if (w < wave) off += s; if (w < 4) bmid += s; ball += s; }
        {
            const float ofs_ = off - bmid;
            float ke[8], q0v_[8]; const float cm_ = ex2(bmid), ca_ = ex2(ball - bmid);
#pragma unroll
            for (int i = 0; i < 8; ++i) {
                const int t = 8 * wave + i; const float qv = bflo((unsigned)*(const LAS bf16*)(lds + RQ + t * SC_P + lane * 2)), kv = bflo((unsigned)*(const LAS bf16*)(lds + RK + t * SC_P + lane * 2));
                const float xc = fminf(fmaxf(g[i] + ofs_, -100.f), 100.f); const float eq = ex2(xc), ek = ex2(-xc);
                const float qm_ = qv * eq, km_ = kv * ek;
                { const unsigned w2_ = pg8::cvt_pk_bf16(qm_, km_);
                  *(LAS unsigned short*)(lds + L::QM + t * SC_P + lane * 2) = (unsigned short)w2_;
                  *(LAS unsigned short*)(lds + L::KM + t * SC_P + lane * 2) = (unsigned short)(w2_ >> 16); }
                q0v_[i] = qm_ * cm_;
                ke[i] = km_ * ca_;
            }
#pragma unroll
            for (int i = 0; i < 8; i += 2) { const int t = 8 * wave + i; const unsigned w2_ = pg8::cvt_pk_bf16(q0v_[i], q0v_[i + 1]);
                *(LAS unsigned short*)(lds + L::Q0 + t * SC_P + lane * 2) = (unsigned short)w2_;
                *(LAS unsigned short*)(lds + L::Q0 + (t + 1) * SC_P + lane * 2) = (unsigned short)(w2_ >> 16); }
            v4u w; w.x = pg8::cvt_pk_bf16(ke[0], ke[1]); w.y = pg8::cvt_pk_bf16(ke[2], ke[3]); w.z = pg8::cvt_pk_bf16(ke[4], ke[5]); w.w = pg8::cvt_pk_bf16(ke[6], ke[7]);
            *(LAS v4u*)(lds + L::KET + lane * SC_P + 16 * wave) = w;
            if (wave == 0) dec[lane] = ex2(ball);
        }
        LDS_BARRIER();
        SCAN_RAW_TO_LDS();
        { const size_t o_ = (tokb + 64 * cnn + srow) * 256 + h * 64 + 8 * sseg; qw_ = *(const v4u*)(Qs + o_); kw_ = *(const v4u*)(Ks + o_); if (!GLA) gw_ = *(const v4u*)(Gs + o_); }
        _Pragma("unroll") for (int q8 = 0; q8 < VPT / 8; ++q8) vraw[q8] = *(const v4u*)(Vs + (tokb + 64 * cn + srow) * (size_t)(4 * DV) + h * DV + VPT * sseg + 8 * q8);
        if (GLA && wave < 4) { SCAN_GATE_BLOCK(cn); SCAN_LRA_LOAD(cnn); }
        if (mma_on) {
            f32x16 o;
#pragma unroll
            for (int i = 0; i < 16; ++i) o[i] = 0.f;
#pragma unroll
            for (int di = 0; di < 2; ++di)
#pragma unroll
                for (int s2 = 0; s2 < 2; ++s2) {
                    const LAS unsigned char* qp = lds + L::Q0 + (32 * ti + r32) * SC_P + (32 * di + 16 * s2 + 4 * hi) * 2;
                    const v2u a_lo = *(const LAS v2u*)qp, a_hi = *(const LAS v2u*)(qp + 16);
                    const v4u aw = {a_lo.x, a_lo.y, a_hi.x, a_hi.y};
                    o = MFMA32(__builtin_bit_cast(bf16x8_t, aw), pack8(di == 0 ? S0 : S1, s2), o);
                }
#pragma unroll
            for (int sj = 0; sj < 2; ++sj) {
                if (sj <= ti) {
                    f32x16 sc;
#pragma unroll
                    for (int i = 0; i < 16; ++i) sc[i] = 0.f;
#pragma unroll
                    for (int ks = 0; ks < 4; ++ks) {
                        const bf16x8_t a = *(const LAS bf16x8_t*)(lds + L::KM + (32 * sj + r32) * SC_P + (16 * ks + 8 * hi) * 2);
                        const bf16x8_t bq = *(const LAS bf16x8_t*)(lds + L::QM + (32 * ti + r32) * SC_P + (16 * ks + 8 * hi) * 2);
                        sc = MFMA32(a, bq, sc);
                    }
#pragma unroll
                    for (int s2 = 0; s2 < 2; ++s2) {
                        v4u pw_ = __builtin_bit_cast(v4u, pack8(sc, s2));
                        if (sj == ti) { pw_.x &= cmask[4 * s2]; pw_.y &= cmask[4 * s2 + 1]; pw_.z &= cmask[4 * s2 + 2]; pw_.w &= cmask[4 * s2 + 3]; }
                        o = MFMA32(__builtin_bit_cast(bf16x8_t, pw_), tr_frag2(lds + L::V, L::VP, 32 * sj + 16 * s2 + 4 * hi, 32 * sj + 16 * s2 + 8 + 4 * hi, 32 * cb, lane), o);
                    }
                }
            }
#pragma unroll
            for (int j4 = 0; j4 < 4; ++j4) {
                const f32x4 d0 = *(const LAS f32x4*)(dec + 8 * j4 + 4 * hi), d1 = *(const LAS f32x4*)(dec + 32 + 8 * j4 + 4 * hi);
#pragma unroll
                for (int e = 0; e < 4; ++e) { S0[4 * j4 + e] *= d0[e]; S1[4 * j4 + e] *= d1[e]; }
            }
#pragma unroll
            for (int ks = 0; ks < 4; ++ks) {
                const bf16x8_t vb = tr_frag2(lds + L::V, L::VP, 16 * ks + 8 * hi, 16 * ks + 8 * hi + 4, 32 * cb, lane);
                const bf16x8_t a0 = *(const LAS bf16x8_t*)(lds + L::KET + r32 * SC_P + (16 * ks + 8 * hi) * 2);
                const bf16x8_t a1 = *(const LAS bf16x8_t*)(lds + L::KET + (32 + r32) * SC_P + (16 * ks + 8 * hi) * 2);
                S0 = MFMA32(a0, vb, S0); S1 = MFMA32(a1, vb, S1);
            }
#pragma unroll
            for (int i = 0; i < 16; ++i) obuf[(32 * ti + crow16(i, hi)) * L::OP + 32 * cb + r32] = o[i];
        }
        LDS_BARRIER();
        {
            const LAS float* orow = obuf + srow * L::OP + CPT * sseg; float x[CPT]; float ss = 0.f;
#pragma unroll
            for (int j = 0; j < CPT; ++j) x[j] = orow[j];
            { float s0_ = 0.f, s1_ = 0.f;
#pragma unroll
              for (int j = 0; j < CPT; j += 2) { s0_ = __builtin_fmaf(x[j], x[j], s0_); s1_ = __builtin_fmaf(x[j + 1], x[j + 1], s1_); }
              ss = s0_ + s1_; }
            ss += __builtin_bit_cast(float, __builtin_amdgcn_update_dpp(0, __builtin_bit_cast(int, ss), 0xB1, 0xF, 0xF, true));
            ss += __builtin_bit_cast(float, __builtin_amdgcn_update_dpp(0, __builtin_bit_cast(int, ss), 0x4E, 0xF, 0xF, true));
            ss += __builtin_bit_cast(float, __builtin_amdgcn_update_dpp(0, __builtin_bit_cast(int, ss), 0x141, 0xF, 0xF, true));
            const float rstd = __builtin_amdgcn_rsqf(ss * (1.0f / DV) + EPS);
            bf16* op = O + (tok0 + srow) * (size_t)D + ocol0 + h * DV + CPT * sseg;
#pragma unroll
            for (int q8 = 0; q8 < CPT / 8; ++q8) { const v4u gg = gateR[q8];
                const float gt[8] = {bflo(gg.x), bfhi(gg.x), bflo(gg.y), bfhi(gg.y), bflo(gg.z), bfhi(gg.z), bflo(gg.w), bfhi(gg.w)}; float y[8];
#pragma unroll
                for (int j = 0; j < 8; ++j) y[j] = x[8 * q8 + j] * rstd * gt[j];
                v4u w; w.x = pg8::cvt_pk_bf16(y[0], y[1]); w.y = pg8::cvt_pk_bf16(y[2], y[3]); w.z = pg8::cvt_pk_bf16(y[4], y[5]); w.w = pg8::cvt_pk_bf16(y[6], y[7]); *(v4u*)(op + 8 * q8) = w; }
            SCAN_GATE_LOAD(cn);
        }
    }
    __syncthreads();
#undef SCAN_GATE_BLOCK
#undef SCAN_LRA_LOAD
#undef SCAN_RAW_LOAD
#undef SCAN_RAW_TO_LDS
#undef SCAN_GATE_LOAD
}
struct RevOrder {
    pg8::StaticOrder S;
    __device__ __forceinline__ bool next(int i, pg8::Unit& u) const { return i < 4 && S.next(3 - i, u); }
    __device__ __forceinline__ void a_ready(const pg8::Unit&) const {}
    __device__ __forceinline__ void done(const pg8::Unit&) const {}
};
struct Args { const float* in[12]; float* out; unsigned char* ws; int ph_lo, ph_hi; };
__global__ void __launch_bounds__(NTHR, 2) fwd_kernel(Args args) {
    extern __shared__ __attribute__((aligned(16))) unsigned char lds_raw[];
    LAS unsigned char* lds = (LAS unsigned char*)lds_raw;
    volatile LAS unsigned* MISC = (volatile LAS unsigned*)(lds + MISC_OFF);
    const int tid = threadIdx.x, lane = tid & 63, wave = __builtin_amdgcn_readfirstlane(tid >> 6);
    const int G = gridDim.x, bx = blockIdx.x, vcu = (G % 8 == 0) ? (bx % 8) * (G / 8) + bx / 8 : bx;
    unsigned char* ws = args.ws;
    gu32* ctl = (gu32*)(ws + WS_CTL);
    const float* x_in = args.in[0]; const float* c_in = args.in[1]; const float* w_ada = args.in[2]; const float* b_ada = args.in[3]; const float* w_in = args.in[4];
    const float* w_g2 = args.in[5]; const float* b_g = args.in[6]; const float* gla_nw = args.in[7]; const float* lb_logits = args.in[8]; const float* hgrn_nw = args.in[9];
    const float* w_out = args.in[10]; const float* final_w = args.in[11];
    bf16* XB = (bf16*)(ws + WS_XB);
    float* ADA = (float*)(ws + WS_ADA); float* LB = (float*)(ws + WS_LB);
    bf16* WIN = (bf16*)(ws + WS_WIN); bf16* WOUT = (bf16*)(ws + WS_WOUT); bf16* HN = (bf16*)(ws + WS_HN); bf16* OB = (bf16*)(ws + WS_O);
    unsigned char* P = ws + WS_P;
    bf16* YB = (bf16*)(ws + WS_P);
    for (int u = tid; u < (LDS_BYTES - LDSCTL_OFF) / 4; u += NTHR) ((LAS unsigned*)(lds + LDSCTL_OFF))[u] = 0u;
    __syncthreads();
    XcdBarrier bar; bar.bar = (unsigned*)(ctl + CW_BAR); bar.x = 0; bar.w = (unsigned)wave; bar.st = nullptr;
    if (!MK_PER_PHASE) bar = xcd_barrier_post((unsigned*)(ctl + CW_BAR), MISC + 8);
    const int lo = args.ph_lo, hi = args.ph_hi;
#define IN(k) (lo <= (k) && (k) < hi)
#define SEAM(k) do { if (IN(k) && IN((k) + 1)) xcd_barrier(bar); } while (0)
    const int gw = vcu * NWAVES + wave, NGW = G * NWAVES;

#ifndef NO_P0
    if (IN(0)) {
        LAS float* scr = (LAS float*)(lds + wave * 16384);
        constexpr int I_IN = (D / 64) * (NIN / 32), I_OUT = (D / 64) * (D / 32), NIT = DEPTH * (I_IN + I_OUT);
#define P0_DEC(it_, W_, WT_, NS_, NB_, WM_, R_) const int l_##R_ = (it_) / (I_IN + I_OUT), R_##x = (it_) % (I_IN + I_OUT); const bool WM_ = R_##x < I_IN; \
            const float* W_ = WM_ ? w_in + (size_t)l_##R_ * D * DIN : w_out + (size_t)l_##R_ * D * D; bf16* WT_ = WM_ ? WIN + (size_t)l_##R_ * NIN * D : WOUT + (size_t)l_##R_ * D * D; \
            const int NS_ = WM_ ? DIN : D, NB_ = WM_ ? NIN / 32 : D / 32, R_ = WM_ ? R_##x : R_##x - I_IN;
        {
            f32x4 cur[8]; int it = gw;
            if (it < NIT) { P0_DEC(it, W0, T0_, NS0, NB0, WM0, r0); p0_tr_load(W0, NS0, NB0, WM0, r0, lane, cur, gla_nw + l_r0 * 128, hgrn_nw + l_r0 * 64); }
            while (it < NIT) {
                const int itn = it + NGW; f32x4 nxt[8];
                if (itn < NIT) { P0_DEC(itn, W1, T1_, NS1, NB1, WM1, r1); p0_tr_load(W1, NS1, NB1, WM1, r1, lane, nxt, gla_nw + l_r1 * 128, hgrn_nw + l_r1 * 64); }
                { P0_DEC(it, W2, T2_, NS2, NB2, WM2, r2); p0_tr_finish(cur, D, NB2, T2_, scr, r2, lane); }
#pragma unroll
                for (int i = 0; i < 8; ++i) cur[i] = nxt[i];
                it = itn;
            }
        }
#undef P0_DEC
        __syncthreads();
        for (int it = vcu; it < DEPTH * 48; it += G) p0_ada_item(c_in, w_ada, b_ada, ADA, (LAS float*)lds, it, tid, wave, lane);
        if (vcu == G - 1 && tid < 256) {
            float lg[4], mx = -INFINITY, sum = 0.f;
#pragma unroll
            for (int l = 0; l < 4; ++l) { lg[l] = lb_logits[l * 256 + tid]; mx = fmaxf(mx, lg[l]); }
#pragma unroll
            for (int l = 0; l < 4; ++l) { lg[l] = expf(lg[l] - mx); sum += lg[l]; }
            const float inv = 1.0f / sum; const float p1 = lg[1] * inv, p2 = lg[2] * inv, p3 = lg[3] * inv;
            LB[tid] = 0.f; LB[256 + tid] = p1; LB[512 + tid] = p1 + p2; LB[768 + tid] = p1 + p2 + p3;
        }
    }
#endif
    SEAM(0);
    if (IN(1)) { int t_ = wave * 64 + pg8::hw_lane(); asm volatile("" : "+v"(t_)); const int gw_ = vcu * NWAVES + __builtin_amdgcn_readfirstlane(t_ >> 6);
        row_pass<true, false, true>(x_in, XB, YB, ADA, ADA, final_w, args.out, XB, HN, gw_, NGW, t_ & 63); }
    SEAM(1);
    for (int l = 0; l < DEPTH; ++l) {
        const int pb = 1 + 3 * l;
        const float* ada_l = ADA + (size_t)l * 32 * 3072;
#ifndef NO_GA
        if (IN(pb + 1)) {
            pg8::Gemm g{HN, WIN + (size_t)l * NIN * D, M, NIN, D, wave}; pg8::StaticOrder S; S.init(M, NIN, G, bx);
            pg8::EpiIn E{P, LB + l * 256};
            pg8::gemm_phase<pg8::EpiIn, pg8::StaticOrder, true, true>(lds, g, S, E);
        }
#endif
        SEAM(pb + 1);
        if (IN(pb + 2)) {
            int tid_b = wave * 64 + pg8::hw_lane(); asm volatile("" : "+v"(tid_b)); const int wave_b = __builtin_amdgcn_readfirstlane(tid_b >> 6);
#ifndef NO_SCAN
            for (int u = vcu; u < 256; u += G) {
                const int b = (u & 127) >> 2, h = u & 3;
                if (u < 128) scan_unit_mfma<128, true>(lds, b, h, (const bf16*)(P + P_QA), (const bf16*)(P + P_KA), nullptr, (const bf16*)(P + P_VA), (const bf16*)(P + P_GA), (const bf16*)(P + P_LRA),
                                                       w_g2 + (size_t)l * 16 * 256, b_g + l * 256, gla_nw + l * 128, OB, 0, tid_b, wave_b);
                else scan_unit_mfma<64, false>(lds, b, h, (const bf16*)(P + P_QB), (const bf16*)(P + P_KB), (const bf16*)(P + P_GFB), (const bf16*)(P + P_IB), (const bf16*)(P + P_GB), nullptr,
                                               nullptr, nullptr, hgrn_nw + l * 64, OB, 512, tid_b, wave_b);
            }
#endif
#ifndef NO_SB
            const bool bal_ = (G == 256); const int sb_n = bal_ ? (vcu < 128 ? 3 : 5) : (1024 - vcu + G - 1) / G, sb_0 = bal_ ? (vcu < 128 ? vcu : 128 + (vcu - 128)) : vcu, sb_s = bal_ ? 128 : G, sb_k = (bal_ && vcu < 128) ? 640 : 0;
            sb_units_pipe(lds, sb_n, sb_0, sb_s, sb_k, (const bf16*)(P + P_QC), (const bf16*)(P + P_KC), (const bf16*)(P + P_VC), (const bf16*)(P + P_GC), OB, tid_b, wave_b);
#endif
        }
        SEAM(pb + 2);
#ifndef NO_GC
        if (IN(pb + 3)) {
            pg8::Gemm g{OB, WOUT + (size_t)l * D * D, M, D, D, wave}; RevOrder S; S.S.init(M, D, G, bx);
            float* part_l = (float*)(ws + WS_PART) + (size_t)l * M * 16; unsigned* cnt_l = (unsigned*)(ctl + CW_PANEL) + l * 256 * 16;
            if (l == 0) { pg8::EpiNorm<true, false> E{x_in, (pg8::bf16_t*)XB, ada_l + 2048, ada_l + 32 * 3072, (pg8::bf16_t*)HN, args.out, part_l, cnt_l}; pg8::gemm_phase<pg8::EpiNorm<true, false>, RevOrder, true, true>(lds, g, S, E); }
            else if (l < DEPTH - 1) { pg8::EpiNorm<false, false> E{x_in, (pg8::bf16_t*)XB, ada_l + 2048, ada_l + 32 * 3072, (pg8::bf16_t*)HN, args.out, part_l, cnt_l}; pg8::gemm_phase<pg8::EpiNorm<false, false>, RevOrder, true, true>(lds, g, S, E); }
            else { pg8::EpiNorm<false, true> E{x_in, (pg8::bf16_t*)XB, ada_l + 2048, final_w, (pg8::bf16_t*)HN, args.out, part_l, cnt_l}; pg8::gemm_phase<pg8::EpiNorm<false, true>, RevOrder, true, true>(lds, g, S, E); }
        }
#endif
        SEAM(pb + 3);
    }
#undef IN
#undef SEAM
}

extern "C" void kernel_launch(void* const* d_in, const int* in_sizes, int n_in, void* d_out, int out_size, void* d_ws, size_t ws_size, hipStream_t stream) {
    static int grid = 0;
    if (grid == 0) {
        if (n_in != 12 || in_sizes[0] != M * D || out_size != M * D || ws_size < WS_END) { fprintf(stderr, "kernel_launch: unexpected shapes / workspace (n_in %d, ws %zu < %zu)\n", n_in, ws_size, (size_t)WS_END); grid = -1; return; }
        int dev = 0, cus = 0, per_cu = 0;
        if (hipGetDevice(&dev) != hipSuccess || hipDeviceGetAttribute(&cus, hipDeviceAttributeMultiprocessorCount, dev) != hipSuccess) { grid = -1; return; }
        if (hipFuncSetAttribute((const void*)fwd_kernel, hipFuncAttributeMaxDynamicSharedMemorySize, LDS_BYTES) != hipSuccess) { fprintf(stderr, "kernel_launch: hipFuncSetAttribute failed\n"); grid = -1; return; }
        if (hipOccupancyMaxActiveBlocksPerMultiprocessor(&per_cu, (const void*)fwd_kernel, NTHR, LDS_BYTES) != hipSuccess || per_cu < 1) fprintf(stderr, "kernel_launch: occupancy query reports %d\n", per_cu);
        (void)hipGetLastError();
        grid = cus;
    }
    if (grid < 0) return;
    if (hipMemsetAsync((char*)d_ws + WS_CTL, 0, CTL_ZERO_BYTES, stream) != hipSuccess) return;
    Args a{};
    for (int i = 0; i < 12; ++i) a.in[i] = (const float*)d_in[i];
    a.out = (float*)d_out; a.ws = (unsigned char*)d_ws;
#if MK_PER_PHASE
    for (int p = 0; p < N_PHASES; ++p) { a.ph_lo = p; a.ph_hi = p + 1; hipLaunchKernelGGL(fwd_kernel, dim3(grid), dim3(NTHR), LDS_BYTES, stream, a); }
#else
    a.ph_lo = 0; a.ph_hi = N_PHASES; hipLaunchKernelGGL(fwd_kernel, dim3(grid), dim3(NTHR), LDS_BYTES, stream, a);
#endif
}
```
